# Optimizing an MI355X kernel written in HIP

```python
import math
import jax, jax.numpy as jnp
from jax import lax
import numpy as np

D_MODEL = 1024
BATCH = 8
SEQ = 2048
DEPTH = 1
DEC_BATCH = 128
DEC_SEQ = 4
PAST_LEN = 16384
PAGE_SIZE = 128

SSM_EXPAND = 2
SSM_D_INNER = SSM_EXPAND * D_MODEL
SSM_HEAD_DIM = 64
SSM_HEADS = SSM_D_INNER // SSM_HEAD_DIM
SSM_GROUPS = 4
SSM_STATE = 128
SSM_CONV = 4
SSM_CONV_DIM = SSM_D_INNER + 2 * SSM_GROUPS * SSM_STATE
DT_MIN = 0.001
DT_MAX = 0.1
RET_HEADS = 4
RET_QK_DIM = D_MODEL // RET_HEADS
RET_V_DIM = 2 * RET_QK_DIM
RET_QK = RET_HEADS * RET_QK_DIM
RET_V = RET_HEADS * RET_V_DIM
ROPE_BASE = 10000.0
D_FF = 2816
CHUNK = 128
NORM_EPS = 1e-6
GATED_NORM_EPS = 1e-5

IN_SPLITS = (SSM_D_INNER, SSM_CONV_DIM, SSM_HEADS, RET_QK, RET_QK, RET_V, RET_V, D_MODEL, D_MODEL)
IN_DIM = sum(IN_SPLITS)
IN_OFFSETS = [int(v) for v in np.cumsum(IN_SPLITS)[:-1]]

kernel_name = 'hybrid_ssd_retention_macaron_step'


def rms_norm(x, g, eps=NORM_EPS):
    xf = x.astype(jnp.float32)
    y = xf * lax.rsqrt(jnp.mean(xf * xf, axis=-1, keepdims=True) + eps)
    return (y * g.astype(jnp.float32)).astype(x.dtype)


def swiglu(x, w1, w3, w2):
    return (jax.nn.silu(x @ w1) * (x @ w3)) @ w2


def causal_conv(xbc, buf, w, b):
    L = xbc.shape[1]
    full = jnp.concatenate([buf, xbc], axis=1)
    out = b + full[:, 0:L] * w[0]
    for k in range(1, SSM_CONV):
        out = out + full[:, k:k + L] * w[k]
    return jax.nn.silu(out), full[:, L:]


def to_chunks(t, nc, q):
    return jnp.moveaxis(t.reshape((t.shape[0], nc, q) + t.shape[2:]), 1, 0)


def ssd_scan(x, dt, a, bm, cm, h0):
    Bsz, L = x.shape[:2]
    q = math.gcd(L, CHUNK)
    nc = L // q
    hg = SSM_HEADS // SSM_GROUPS
    xs = to_chunks(x.reshape(Bsz, L, SSM_GROUPS, hg, SSM_HEAD_DIM), nc, q)
    dts = to_chunks(dt.reshape(Bsz, L, SSM_GROUPS, hg), nc, q)
    bs = to_chunks(bm, nc, q)
    cs = to_chunks(cm, nc, q)
    a_g = a.reshape(SSM_GROUPS, hg)
    causal = jnp.tril(jnp.ones((q, q), dtype=bool))[None, :, :, None, None]

    def step(h, inp):
        xc, dtc, bc, cc = inp
        la = jnp.cumsum(dtc * a_g, axis=1)
        seg = la[:, :, None] - la[:, None, :]
        decay = jnp.exp(jnp.where(causal, seg, -jnp.inf))
        cb = jnp.einsum('btgn,bsgn->btsg', cc, bc)
        w = cb[..., None] * decay * dtc[:, None]
        y = jnp.einsum('btsgh,bsghp->btghp', w, xc)
        y = y + jnp.einsum('btgn,bghpn->btghp', cc, h) * jnp.exp(la)[..., None]
        tail = jnp.exp(la[:, -1:] - la) * dtc
        h = h * jnp.exp(la[:, -1])[..., None, None] + jnp.einsum('bsgn,bsgh,bsghp->bghpn', bc, tail, xc)
        return h, y

    h0g = h0.reshape(Bsz, SSM_GROUPS, hg, SSM_HEAD_DIM, SSM_STATE)
    h, ys = lax.scan(step, h0g, (xs, dts, bs, cs))
    y = jnp.moveaxis(ys, 0, 1).reshape(Bsz, L, SSM_HEADS, SSM_HEAD_DIM)
    return y, h.reshape(Bsz, SSM_HEADS, SSM_HEAD_DIM, SSM_STATE)


def ret_log_decay():
    return jnp.log1p(-jnp.exp2(-5.0 - jnp.arange(RET_HEADS, dtype=jnp.float32)))


def retention_scan(q, k, v, h0):
    Bsz, L = q.shape[:2]
    c = math.gcd(L, CHUNK)
    nc = L // c
    lg = ret_log_decay()
    idx = jnp.arange(c, dtype=jnp.float32)
    rel = idx[:, None] - idx[None, :]
    dmat = jnp.where((rel >= 0)[..., None], jnp.exp(jnp.maximum(rel, 0.0)[..., None] * lg), 0.0)
    dmat = dmat.transpose(2, 0, 1)
    q_dec = jnp.exp((idx + 1.0)[:, None] * lg)[:, :, None]
    k_dec = jnp.exp((c - 1.0 - idx)[:, None] * lg)[:, :, None]
    chunk_dec = jnp.exp(c * lg)[:, None, None]

    def step(h, inp):
        qc, kc, vc = inp
        s = jnp.einsum('bthd,bshd->bhts', qc, kc) * dmat
        y = jnp.einsum('bhts,bshe->bthe', s, vc)
        y = y + jnp.einsum('bthd,bhde->bthe', qc * q_dec, h)
        h = h * chunk_dec + jnp.einsum('bshd,bshe->bhde', kc * k_dec, vc)
        return h, y

    h, ys = lax.scan(step, h0, (to_chunks(q, nc, c), to_chunks(k, nc, c), to_chunks(v, nc, c)))
    y = jnp.moveaxis(ys, 0, 1).reshape(Bsz, L, RET_HEADS, RET_V_DIM)
    return y, h


def rotary(t, pos):
    half = RET_QK_DIM // 2
    inv = ROPE_BASE ** (-jnp.arange(half, dtype=jnp.float32) / half)
    ang = pos[:, None] * inv
    cos = jnp.cos(ang)[None, :, None]
    sin = jnp.sin(ang)[None, :, None]
    t1, t2 = t[..., :half], t[..., half:]
    return jnp.concatenate([t1 * cos - t2 * sin, t1 * sin + t2 * cos], axis=-1)


def trunk_layer(x, pos0, ssm_h0, conv_buf, ret_h0, p):
    Bsz, L, _ = x.shape
    f32 = jnp.float32
    h = x + 0.5 * swiglu(rms_norm(x, p['norm_ffn1']), p['ffn1_w1'], p['ffn1_w3'], p['ffn1_w2'])
    u = rms_norm(h, p['norm_mix'])
    proj = u @ p['w_in']
    z, xbc, dt_raw, rq, rk, rv, rg, ga, gb = jnp.split(proj, IN_OFFSETS, axis=-1)
    xbc_c, conv_new = causal_conv(xbc, conv_buf.astype(xbc.dtype), p['conv_w'], p['conv_b'])
    xs, bm, cm = jnp.split(xbc_c.astype(f32), [SSM_D_INNER, SSM_D_INNER + SSM_GROUPS * SSM_STATE], axis=-1)
    dt = jax.nn.softplus(dt_raw.astype(f32) + p['dt_bias'].astype(f32))
    a = -jnp.exp(p['a_log'].astype(f32))
    xh = xs.reshape(Bsz, L, SSM_HEADS, SSM_HEAD_DIM)
    y_ssm, ssm_new = ssd_scan(xh, dt, a,
                              bm.reshape(Bsz, L, SSM_GROUPS, SSM_STATE),
                              cm.reshape(Bsz, L, SSM_GROUPS, SSM_STATE),
                              ssm_h0.astype(f32))
    y_ssm = y_ssm + p['ssm_d'].astype(f32)[:, None] * xh
    y_ssm = y_ssm.reshape(Bsz, L, SSM_D_INNER) * jax.nn.silu(z.astype(f32))
    y_ssm = rms_norm(y_ssm, p['ssm_norm'], GATED_NORM_EPS).astype(x.dtype)
    branch_ssm = y_ssm @ p['w_branch_ssm']
    pos = pos0 + jnp.arange(L, dtype=f32)
    q = rotary(rq.astype(f32).reshape(Bsz, L, RET_HEADS, RET_QK_DIM), pos)
    k = rotary(rk.astype(f32).reshape(Bsz, L, RET_HEADS, RET_QK_DIM), pos) * (RET_QK_DIM ** -0.5)
    v = rv.astype(f32).reshape(Bsz, L, RET_HEADS, RET_V_DIM)
    y_ret, ret_new = retention_scan(q, k, v, ret_h0.astype(f32))
    y_ret = rms_norm(y_ret, p['ret_norm'].reshape(RET_HEADS, RET_V_DIM), NORM_EPS).reshape(Bsz, L, RET_V)
    y_ret = (jax.nn.silu(rg.astype(f32)) * y_ret).astype(x.dtype)
    branch_ret = y_ret @ p['w_branch_ret']
    merged = jax.nn.sigmoid(ga) * branch_ssm + jax.nn.sigmoid(gb) * branch_ret
    h = h + merged @ p['w_out']
    h = h + 0.5 * swiglu(rms_norm(h, p['norm_ffn2']), p['ffn2_w1'], p['ffn2_w3'], p['ffn2_w2'])
    return h, ssm_new, conv_new, ret_new


def setup_inputs(seed: int = 0) -> dict:
    key = jax.random.key(seed)
    ks = iter(jax.random.split(key, 32))

    def nrm(shape, scale):
        return jax.random.normal(next(ks), shape, jnp.float32) * scale

    def gain(shape):
        return 1.0 + nrm(shape, 0.02)

    dt0 = jnp.exp(jax.random.uniform(next(ks), (DEPTH, SSM_HEADS), jnp.float32,
                                     minval=math.log(DT_MIN), maxval=math.log(DT_MAX)))
    dt_bias = dt0 + jnp.log(-jnp.expm1(-dt0))
    a_log = jnp.log(jax.random.uniform(next(ks), (DEPTH, SSM_HEADS), jnp.float32, minval=1.0, maxval=16.0))
    return {
        'x_prompt': nrm((BATCH, SEQ, D_MODEL), 1.0),
        'x_sample': nrm((DEC_BATCH, DEC_SEQ, D_MODEL), 1.0),
        'state_ssm': nrm((DEPTH, DEC_BATCH, SSM_HEADS, SSM_HEAD_DIM, SSM_STATE), 0.1),
        'state_conv': nrm((DEPTH, DEC_BATCH, SSM_CONV - 1, SSM_CONV_DIM), 1.0),
        'state_ret': nrm((DEPTH, DEC_BATCH, RET_HEADS, RET_QK_DIM, RET_V_DIM), 0.5),
        'norm_ffn1': gain((DEPTH, D_MODEL)),
        'ffn1_w1': nrm((DEPTH, D_MODEL, D_FF), D_MODEL ** -0.5),
        'ffn1_w3': nrm((DEPTH, D_MODEL, D_FF), D_MODEL ** -0.5),
        'ffn1_w2': nrm((DEPTH, D_FF, D_MODEL), D_FF ** -0.5),
        'norm_mix': gain((DEPTH, D_MODEL)),
        'w_in': nrm((DEPTH, D_MODEL, IN_DIM), D_MODEL ** -0.5),
        'conv_w': nrm((DEPTH, SSM_CONV, SSM_CONV_DIM), SSM_CONV ** -0.5),
        'conv_b': nrm((DEPTH, SSM_CONV_DIM), 0.02),
        'dt_bias': dt_bias,
        'a_log': a_log,
        'ssm_d': 1.0 + nrm((DEPTH, SSM_HEADS), 0.1),
        'ssm_norm': gain((DEPTH, SSM_D_INNER)),
        'ret_norm': gain((DEPTH, RET_V)),
        'w_branch_ssm': nrm((DEPTH, SSM_D_INNER, D_MODEL), SSM_D_INNER ** -0.5),
        'w_branch_ret': nrm((DEPTH, RET_V, D_MODEL), RET_V ** -0.5),
        'w_out': nrm((DEPTH, D_MODEL, D_MODEL), D_MODEL ** -0.5),
        'norm_ffn2': gain((DEPTH, D_MODEL)),
        'ffn2_w1': nrm((DEPTH, D_MODEL, D_FF), D_MODEL ** -0.5),
        'ffn2_w3': nrm((DEPTH, D_MODEL, D_FF), D_MODEL ** -0.5),
        'ffn2_w2': nrm((DEPTH, D_FF, D_MODEL), D_FF ** -0.5),
        'norm_final': gain((D_MODEL,)),
    }


def reference(x_prompt, x_sample, state_ssm, state_conv, state_ret,
              norm_ffn1, ffn1_w1, ffn1_w3, ffn1_w2, norm_mix, w_in, conv_w, conv_b,
              dt_bias, a_log, ssm_d, ssm_norm, ret_norm, w_branch_ssm, w_branch_ret, w_out,
              norm_ffn2, ffn2_w1, ffn2_w3, ffn2_w2, norm_final):
    bp = x_prompt.shape[0]
    hp, hs = x_prompt, x_sample
    ssm_p, conv_p, ret_p, ssm_s, conv_s, ret_s = [], [], [], [], [], []
    for l in range(DEPTH):
        p = dict(norm_ffn1=norm_ffn1[l], ffn1_w1=ffn1_w1[l], ffn1_w3=ffn1_w3[l], ffn1_w2=ffn1_w2[l],
                 norm_mix=norm_mix[l], w_in=w_in[l], conv_w=conv_w[l], conv_b=conv_b[l],
                 dt_bias=dt_bias[l], a_log=a_log[l], ssm_d=ssm_d[l], ssm_norm=ssm_norm[l],
                 ret_norm=ret_norm[l], w_branch_ssm=w_branch_ssm[l], w_branch_ret=w_branch_ret[l],
                 w_out=w_out[l], norm_ffn2=norm_ffn2[l], ffn2_w1=ffn2_w1[l], ffn2_w3=ffn2_w3[l],
                 ffn2_w2=ffn2_w2[l])
        hp, a1, b1, c1 = trunk_layer(
            hp, 0.0,
            jnp.zeros((bp, SSM_HEADS, SSM_HEAD_DIM, SSM_STATE), jnp.float32),
            jnp.zeros((bp, SSM_CONV - 1, SSM_CONV_DIM), x_prompt.dtype),
            jnp.zeros((bp, RET_HEADS, RET_QK_DIM, RET_V_DIM), jnp.float32), p)
        hs, a2, b2, c2 = trunk_layer(hs, float(PAST_LEN), state_ssm[l], state_conv[l], state_ret[l], p)
        ssm_p.append(a1); conv_p.append(b1); ret_p.append(c1)
        ssm_s.append(a2); conv_s.append(b2); ret_s.append(c2)
    y_prompt = rms_norm(hp, norm_final)
    y_sample = rms_norm(hs, norm_final)
    return (y_prompt, y_sample,
            jnp.stack(ssm_p).astype(state_ssm.dtype), jnp.stack(conv_p).astype(state_conv.dtype),
            jnp.stack(ret_p).astype(state_ret.dtype),
            jnp.stack(ssm_s).astype(state_ssm.dtype), jnp.stack(conv_s).astype(state_conv.dtype),
            jnp.stack(ret_s).astype(state_ret.dtype))
```

```cpp
#include <hip/hip_runtime.h>
#include <hip/hip_cooperative_groups.h>
#include <cstdio>
#include <cstdint>
namespace cg = cooperative_groups;
namespace pg8 {
#define PG8_LAS __attribute__((address_space(3)))
typedef unsigned short bf16_t;
typedef short bf16x8 __attribute__((ext_vector_type(8)));
typedef float f32x4 __attribute__((ext_vector_type(4)));
typedef unsigned u32x4 __attribute__((ext_vector_type(4)));
constexpr int BM = 256, BK = 64, HALF = 128, HTB = HALF * BK * 2  , STAGE_BYTES = 8 * HTB, NXCD = 8, WGM = 2;

__host__ __device__ __forceinline__ int lds_byte(int r, int c) { const int st = (r >> 4) * 2 + (c >> 5), rr = r & 15, cc = c & 31, ob = rr * 64 + cc * 2; return st * 1024 + (ob ^ (((ob >> 9) & 1) << 5)); }
__host__ __device__ __forceinline__ void stage_rc(int b, int& R, int& C) { const int st = b / 1024, sb = b % 1024, swz = sb ^ (((sb >> 9) & 1) << 5); R = (st >> 1) * 16 + swz / 64; C = (st & 1) * 32 + (swz % 64) / 2; }
__host__ __device__ __forceinline__ int perm32(int rho) { const int n = rho >> 4, i = rho & 15; return 8 * (i >> 2) + 4 * n + (i & 3); }

struct Unit { int pm, pn, kofs, nt, split, ks; };
struct Gemm { const bf16_t* A; const bf16_t* Bt; int M, N, K, lda, ldb; };

struct StaticOrder {
    int nM, nN, nwg, G, c, ntf;
    __host__ __device__ __forceinline__ void init(int M, int N, int K, int G_, int c_) { nM = M / BM; nN = N / BM; nwg = nM * nN; G = G_; c = c_; ntf = K / BK; }
    __host__ __device__ __forceinline__ void map(int wgid, int& pm, int& pn) const {
        { const int q = nwg / NXCD, r = nwg % NXCD, xcd = wgid % NXCD, off = wgid / NXCD; wgid = (xcd < r ? xcd * (q + 1) : r * (q + 1) + (xcd - r) * q) + off; }
        const int nig = WGM * nN, gid = wgid / nig, fm = gid * WGM, gsz = (nM - fm) < WGM ? (nM - fm) : WGM;
        pm = fm + ((wgid % nig) % gsz); pn = (wgid % nig) / gsz;
    }
    __host__ __device__ __forceinline__ bool next(int i, Unit& u) const {
        const long L = (long)i * G + c; const bool ok = L < nwg; int pm, pn; map(ok ? (int)L : 0, pm, pn);
        u.pm = pm; u.pn = pn; u.kofs = 0; u.nt = ntf; u.split = 0; u.ks = 0; return ok;
    }
    __device__ __forceinline__ void a_ready(const Unit&) const {}
    __device__ __forceinline__ void done(const Unit&) const {}
};

struct SplitOrder {
    StaticOrder so; int S, Kc, G, c, nfull;
    __host__ __device__ __forceinline__ void init(int N, int K, int Kc_, int G_, int c_) { so.init(16384, N, K, G_, c_); S = K / Kc_; Kc = Kc_; G = G_; c = c_; nfull = so.nwg; }
    __host__ __device__ __forceinline__ bool next(int i, Unit& u) const {
        const long L = (long)i * G + c; const bool full = L < nfull; int pm, pn; so.map(full ? (int)L : 0, pm, pn);
        const long L2l = L - nfull; const bool sp = !full && L2l < 8 * S; const int L2 = sp ? (int)L2l : 0, per = 4 * S, rem = L2 % per, ks = rem % S;
        u.pm = full ? pm : 64 + L2 / per; u.pn = full ? pn : rem / S; u.ks = full ? 0 : ks; u.kofs = full ? 0 : ks * Kc * 2; u.nt = full ? so.ntf : Kc / BK; u.split = full ? 0 : 1;
        return full || sp;
    }
    __device__ __forceinline__ void a_ready(const Unit&) const {}
    __device__ __forceinline__ void done(const Unit&) const {}
};

typedef __bf16 bf16x2v __attribute__((ext_vector_type(2)));
typedef float f32x2v __attribute__((ext_vector_type(2)));
__device__ __forceinline__ unsigned cvt_pk_bf16(float lo, float hi) { const f32x2v v = {lo, hi}; return __builtin_bit_cast(unsigned, __builtin_convertvector(v, bf16x2v)); }
template <class Epi, class Sched, bool ALIGN_EPI = false, bool SP2 = false>
__device__ __forceinline__ void gemm_phase(PG8_LAS unsigned char* lds, const Gemm g, const Sched& S, const Epi& E) {
    int tid_ = threadIdx.x; asm volatile("" : "+v"(tid_));
    const int tid = tid_, wid = __builtin_amdgcn_readfirstlane(tid >> 6), lane = tid & 63, wr = wid >> 2, wc = wid & 3, fr = lane & 15, fq = lane >> 4;
    unsigned voffA[2], voffB[2];
#pragma unroll
    for (int i = 0; i < 2; ++i) { int R, C; stage_rc(tid * 16 + i * 8192, R, C); const int Rb = Epi::PERM ? ((R & ~31) + perm32(R & 31)) : R;
        voffA[i] = (unsigned)(R * g.lda + C) * 2u; voffB[i] = (unsigned)(Rb * g.ldb + C) * 2u; }
    const size_t kstep = (size_t)(BK * 2);
    const size_t hstepA = (size_t)HALF * g.lda * 2, hstepB = (size_t)HALF * g.ldb * 2;
    const size_t tstepA = 2 * hstepA, tstepB = 2 * hstepB;
    const unsigned ldsw = (unsigned)wid * 1024u;
    const int aoff = lds_byte(wr * 64 + fr, fq * 8), boff = lds_byte(wc * 32 + fr, fq * 8);
#define PG8_SA(b, h) (((b) * 2 + (h)) * HTB)
#define PG8_SB(b, h) ((4 + (b) * 2 + (h)) * HTB)
#define PG8_STAGE(bufoff, gbase, voff) do { _Pragma("unroll") for (int _i = 0; _i < 2; ++_i) \
        __builtin_amdgcn_global_load_lds((const unsigned*)((const char*)(gbase) + (voff)[_i]), (PG8_LAS unsigned*)(lds + (bufoff) + ldsw + _i * 8192), 16, 0, 0); } while (0)
#define PG8_LDA(dst, b, h) do { _Pragma("unroll") for (int m = 0; m < 4; ++m) _Pragma("unroll") for (int k = 0; k < 2; ++k) dst[m][k] = *(const PG8_LAS bf16x8*)(lds + PG8_SA(b, h) + aoff + m * 2048 + k * 1024); } while (0)
#define PG8_LDB(dst, b, h) do { _Pragma("unroll") for (int n = 0; n < 2; ++n) _Pragma("unroll") for (int k = 0; k < 2; ++k) dst[n][k] = *(const PG8_LAS bf16x8*)(lds + PG8_SB(b, h) + boff + n * 2048 + k * 1024); } while (0)
#define PG8_MMA(ai, bj, At, Bt) do { __builtin_amdgcn_s_setprio(1); _Pragma("unroll") for (int m = 0; m < 4; ++m) _Pragma("unroll") for (int n = 0; n < 2; ++n) _Pragma("unroll") for (int k = 0; k < 2; ++k) \
        acc[ai][bj][m][n] = __builtin_amdgcn_mfma_f32_16x16x32_bf16(Bt[n][k], At[m][k], acc[ai][bj][m][n], 0, 0, 0); __builtin_amdgcn_s_setprio(0); } while (0)
#define PG8_WAIT_V(n) asm volatile("s_waitcnt vmcnt(" #n ")" ::: "memory")
#define PG8_WAIT_L(n) asm volatile("s_waitcnt lgkmcnt(" #n ")" ::: "memory")
#define PG8_BAR __builtin_amdgcn_s_barrier()
#define PG8_SCHED __builtin_amdgcn_sched_barrier(0)
    Unit cur, nxt; int ui = 0;
    if (!S.next(0, cur)) return;
    f32x4 acc[2][2][4][2];
#pragma unroll
    for (int a = 0; a < 2; ++a)
#pragma unroll
        for (int b = 0; b < 2; ++b)
#pragma unroll
            for (int m = 0; m < 4; ++m)
#pragma unroll
                for (int n = 0; n < 2; ++n) acc[a][b][m][n] = (f32x4){0.f, 0.f, 0.f, 0.f};
    bf16x8 At[4][2], B0[2][2], B1[2][2];
    const char* cA = (const char*)g.A + (size_t)cur.pm * tstepA + cur.kofs; const char* cB = (const char*)g.Bt + (size_t)cur.pn * tstepB + cur.kofs;
    S.a_ready(cur);
    if constexpr (SP2) {
        PG8_STAGE(PG8_SB(0, 0), cB, voffB); PG8_STAGE(PG8_SB(0, 1), cB + hstepB, voffB); PG8_STAGE(PG8_SA(0, 0), cA, voffA); PG8_STAGE(PG8_SA(0, 1), cA + hstepA, voffA);
        if (wr == 1) PG8_BAR;
        PG8_WAIT_V(2); PG8_BAR;
        PG8_STAGE(PG8_SB(1, 0), cB + kstep, voffB); PG8_STAGE(PG8_SA(1, 0), cA + kstep, voffA); PG8_STAGE(PG8_SB(1, 1), cB + hstepB + kstep, voffB);
        PG8_WAIT_V(6); PG8_BAR;
    } else {
        PG8_STAGE(PG8_SB(0, 0), cB, voffB); PG8_STAGE(PG8_SA(0, 0), cA, voffA); PG8_STAGE(PG8_SB(0, 1), cB + hstepB, voffB); PG8_STAGE(PG8_SA(0, 1), cA + hstepA, voffA);
        if (wr == 1) PG8_BAR;
        PG8_WAIT_V(4); PG8_BAR;
        PG8_STAGE(PG8_SB(1, 0), cB + kstep, voffB); PG8_STAGE(PG8_SA(1, 0), cA + kstep, voffA); PG8_STAGE(PG8_SB(1, 1), cB + hstepB + kstep, voffB);
        PG8_WAIT_V(6); PG8_BAR;
    }
    for (;;) {
        const bool has_next = S.next(ui + 1, nxt);
        const char* nA = has_next ? (const char*)g.A + (size_t)nxt.pm * tstepA + nxt.kofs : cA; const char* nB = has_next ? (const char*)g.Bt + (size_t)nxt.pn * tstepB + nxt.kofs : cB;
        const int nt = cur.nt;
        for (int t = 0; t < nt; t += 2) {
            const bool last = (t == nt - 2);
            const char* a1 = cA + (size_t)(t + 1) * kstep;
            const char* a2 = last ? nA : cA + (size_t)(t + 2) * kstep; const char* b2 = last ? nB : cB + (size_t)(t + 2) * kstep;
            const char* a3 = a2 + kstep; const char* b3 = b2 + kstep;
            if (last && has_next) S.a_ready(nxt);
            if constexpr (SP2) {
            PG8_LDB(B0, 0, 0); PG8_LDB(B1, 0, 1); PG8_SCHED; PG8_LDA(At, 0, 0); PG8_STAGE(PG8_SA(1, 1), a1 + hstepA, voffA);
            PG8_WAIT_V(8); PG8_WAIT_L(0); PG8_BAR; PG8_MMA(0, 0, At, B0); PG8_MMA(0, 1, At, B1); PG8_BAR; PG8_SCHED;
            PG8_LDA(At, 0, 1); PG8_STAGE(PG8_SB(0, 0), b2, voffB); PG8_STAGE(PG8_SB(0, 1), b2 + hstepB, voffB); PG8_STAGE(PG8_SA(0, 0), a2, voffA);
            PG8_WAIT_V(8); PG8_WAIT_L(0); PG8_BAR; PG8_MMA(1, 0, At, B0); PG8_MMA(1, 1, At, B1); PG8_BAR; PG8_SCHED;
            PG8_LDB(B0, 1, 0); PG8_LDB(B1, 1, 1); PG8_SCHED; PG8_LDA(At, 1, 0); PG8_STAGE(PG8_SA(0, 1), a2 + hstepA, voffA);
            PG8_WAIT_V(8); PG8_WAIT_L(0); PG8_BAR; PG8_MMA(0, 0, At, B0); PG8_MMA(0, 1, At, B1); PG8_BAR; PG8_SCHED;
            PG8_LDA(At, 1, 1); PG8_STAGE(PG8_SB(1, 0), b3, voffB); PG8_STAGE(PG8_SB(1, 1), b3 + hstepB, voffB); PG8_STAGE(PG8_SA(1, 0), a3, voffA);
            PG8_WAIT_V(8); PG8_WAIT_L(0); PG8_BAR; PG8_MMA(1, 0, At, B0); PG8_MMA(1, 1, At, B1); PG8_BAR; PG8_SCHED;
            } else {
            PG8_LDB(B0, 0, 0); PG8_SCHED; PG8_LDA(At, 0, 0); PG8_STAGE(PG8_SA(1, 1), a1 + hstepA, voffA);
            PG8_WAIT_L(8); PG8_BAR; PG8_WAIT_L(0); PG8_MMA(0, 0, At, B0); PG8_BAR; PG8_SCHED;
            PG8_LDB(B1, 0, 1); PG8_STAGE(PG8_SB(0, 0), b2, voffB);
            PG8_BAR; PG8_WAIT_L(0); PG8_MMA(0, 1, At, B1); PG8_BAR;
            PG8_LDA(At, 0, 1); PG8_STAGE(PG8_SA(0, 0), a2, voffA);
            PG8_BAR; PG8_WAIT_L(0); PG8_MMA(1, 0, At, B0); PG8_BAR; PG8_SCHED;
            PG8_STAGE(PG8_SB(0, 1), b2 + hstepB, voffB);
            PG8_WAIT_V(6); PG8_BAR; PG8_MMA(1, 1, At, B1); PG8_BAR;
            PG8_LDB(B0, 1, 0); PG8_SCHED; PG8_LDA(At, 1, 0); PG8_STAGE(PG8_SA(0, 1), a2 + hstepA, voffA);
            PG8_WAIT_L(8); PG8_BAR; PG8_WAIT_L(0); PG8_MMA(0, 0, At, B0); PG8_BAR; PG8_SCHED;
            PG8_LDB(B1, 1, 1); PG8_STAGE(PG8_SB(1, 0), b3, voffB);
            PG8_BAR; PG8_WAIT_L(0); PG8_MMA(0, 1, At, B1); PG8_BAR;
            PG8_LDA(At, 1, 1); PG8_STAGE(PG8_SA(1, 0), a3, voffA);
            PG8_BAR; PG8_WAIT_L(0); PG8_MMA(1, 0, At, B0); PG8_BAR; PG8_SCHED;
            PG8_STAGE(PG8_SB(1, 1), b3 + hstepB, voffB);
            PG8_WAIT_V(6); PG8_BAR; PG8_MMA(1, 1, At, B1); PG8_BAR;
            }
        }
        if constexpr (ALIGN_EPI) { if (wr == 0) PG8_BAR; }
        if constexpr (!Epi::AFTER_DRAIN) { E(acc, cur, wr, wc, fr, fq); S.done(cur); }
        if (!has_next) break;
#pragma unroll
        for (int a = 0; a < 2; ++a)
#pragma unroll
            for (int b = 0; b < 2; ++b)
#pragma unroll
                for (int m = 0; m < 4; ++m)
#pragma unroll
                    for (int n = 0; n < 2; ++n) acc[a][b][m][n] = (f32x4){0.f, 0.f, 0.f, 0.f};
        cur = nxt; cA = nA; cB = nB; ++ui;
        if constexpr (ALIGN_EPI) { if (wr == 1) PG8_BAR; }
    }
    PG8_WAIT_V(0);
    if constexpr (!ALIGN_EPI) { if (wr == 0) PG8_BAR; }
    PG8_BAR;
    if constexpr (Epi::AFTER_DRAIN) { E.fused(acc, cur, wr, wc, fr, fq, lds, wid, lane); S.done(cur); }
#undef PG8_SA
#undef PG8_SB
#undef PG8_STAGE
#undef PG8_LDA
#undef PG8_LDB
#undef PG8_MMA
#undef PG8_WAIT_V
#undef PG8_WAIT_L
#undef PG8_BAR
#undef PG8_SCHED
}
}

#define LAS __attribute__((address_space(3)))
typedef unsigned short bf16;
typedef pg8::bf16x8 bf16x8;
typedef pg8::f32x4 f32x4;
typedef pg8::u32x4 u32x4;
typedef unsigned u32x2 __attribute__((ext_vector_type(2)));
constexpr int T = 16896, TP = 16384, DM = 1024, FF = 2816, NPROJ = 13312, NPK = 13568, SEQ = 2048;
constexpr int PZ = 0, PXBC = 2048, PQ = 5120, PK = 6144, PV = 7168, PRG = 9216, PGA = 11264, PGB = 12288;
constexpr int NTHR = 512, NWV = 8;
constexpr int LDS_BYTES = 160 * 1024;

constexpr size_t al256(size_t x) { return (x + 255) & ~(size_t)255; }
constexpr size_t WS_W13A = 0;
constexpr size_t WS_W13B = WS_W13A + al256((size_t)5632 * 1024 * 2);
constexpr size_t WS_W2A  = WS_W13B + al256((size_t)5632 * 1024 * 2);
constexpr size_t WS_W2B  = WS_W2A + al256((size_t)1024 * 2816 * 2);
constexpr size_t WS_WIN  = WS_W2B + al256((size_t)1024 * 2816 * 2);
constexpr size_t WS_WBS  = WS_WIN + al256((size_t)NPK * 1024 * 2);
constexpr size_t WS_WBR  = WS_WBS + al256((size_t)1024 * 2048 * 2);
constexpr size_t WS_WO   = WS_WBR + al256((size_t)1024 * 2048 * 2);
constexpr size_t WS_XN   = WS_WO + al256((size_t)1024 * 1024 * 2);
constexpr size_t WS_ACT  = WS_XN + al256((size_t)T * 1024 * 2);
constexpr size_t WS_H1   = WS_ACT + al256((size_t)T * FF * 2);
constexpr size_t WS_PROJ = WS_H1 + al256((size_t)T * 1024 * 4);
constexpr size_t WS_DT   = WS_PROJ + al256((size_t)T * NPROJ * 2);
constexpr size_t WS_XBCC = WS_DT + al256((size_t)T * 32 * 4);
constexpr size_t WS_Y    = WS_XBCC + al256((size_t)T * 3072 * 2);
constexpr size_t WS_ROPE = WS_Y + al256((size_t)T * 4096 * 2);
constexpr size_t WS_SSQS = WS_ROPE + al256((size_t)2052 * 128 * 2 * 4);
constexpr size_t WS_SSQR = WS_SSQS + al256((size_t)T * 4);
constexpr size_t WS_BAR  = WS_SSQR + al256((size_t)T * 16);
constexpr size_t WS_PARTS = WS_BAR + 16384;
constexpr size_t WS_DUM  = WS_PARTS + (size_t)16 * 512 * 1024 * 4;
constexpr size_t WS_END  = WS_DUM + al256((size_t)T * 20);

constexpr size_t O_Y = 0, O_SSMP = (size_t)T * 1024, O_CONVP = O_SSMP + (size_t)8 * 32 * 64 * 128, O_RETP = O_CONVP + (size_t)8 * 3 * 3072,
                 O_SSMS = O_RETP + (size_t)8 * 4 * 256 * 512, O_CONVS = O_SSMS + (size_t)128 * 32 * 64 * 128, O_RETS = O_CONVS + (size_t)128 * 3 * 3072;

struct Params { const float* in[26]; float* out; unsigned char* ws; };
enum { I_XP = 0, I_XS, I_SSSM, I_SCONV, I_SRET, I_NF1, I_F1W1, I_F1W3, I_F1W2, I_NMIX, I_WIN, I_CONVW, I_CONVB, I_DTB, I_ALOG, I_SSMD, I_SSMN, I_RETN,
       I_WBS, I_WBR, I_WO, I_NF2, I_F2W1, I_F2W3, I_F2W2, I_NFIN };

#define DI __device__ __forceinline__
#define LDS_WAIT() asm volatile("s_waitcnt lgkmcnt(0)" ::: "memory")
#define LBAR() do { asm volatile("s_waitcnt lgkmcnt(0)" ::: "memory"); __builtin_amdgcn_s_barrier(); asm volatile("" ::: "memory"); } while (0)
typedef _Float16 h2_t __attribute__((ext_vector_type(2)));
DI float h2lo(unsigned w) { return (float)__builtin_bit_cast(h2_t, w).x; }
DI float h2hi(unsigned w) { return (float)__builtin_bit_cast(h2_t, w).y; }
DI float bflo(unsigned w) { return __uint_as_float(w << 16); }
DI float bfhi(unsigned w) { return __uint_as_float(w & 0xffff0000u); }
typedef __bf16 bf16x2_t __attribute__((ext_vector_type(2)));
typedef float f32x2_t __attribute__((ext_vector_type(2)));
DI unsigned pk2(float lo, float hi) { const f32x2_t v = {lo, hi}; return __builtin_bit_cast(unsigned, __builtin_convertvector(v, bf16x2_t)); }
DI unsigned f2bf(float f) { return pk2(f, 0.f) & 0xffffu; }
DI float sigm(float x) { return __builtin_amdgcn_rcpf(1.f + __expf(-x)); }
DI float silu(float x) { return x * __builtin_amdgcn_rcpf(1.f + __expf(-x)); }
DI float wave_sum(float v) {
#pragma unroll
    for (int o = 1; o < 64; o <<= 1) v += __shfl_xor(v, o);
    return v;
}
DI f32x4 mfma16(bf16x8 a, bf16x8 b, f32x4 c) { return __builtin_amdgcn_mfma_f32_16x16x32_bf16(a, b, c, 0, 0, 0); }
DI bf16x8 ldsfrag(const LAS unsigned char* p) { return *(const LAS bf16x8*)p; }

#define XB_TMO      128
#define XB_XCNT(j)  (256  + 64 * (j))
#define XB_XSUB(j)  (1280 + 64 * (j))
#define XB_XGEN(j)  (2304 + 64 * (j))
#define XB_TOP      3328
#define XB_TOPGEN   3392
#define XCD_BAR_WORDS 3456
#define XB_SPIN_CAP (1u << 18)

__device__ __forceinline__ unsigned xb_ld(unsigned* p)              { return __hip_atomic_load(p, __ATOMIC_RELAXED, __HIP_MEMORY_SCOPE_AGENT); }
__device__ __forceinline__ unsigned xb_add(unsigned* p, unsigned v) { return __hip_atomic_fetch_add(p, v, __ATOMIC_RELAXED, __HIP_MEMORY_SCOPE_AGENT); }
__device__ __forceinline__ unsigned xb_xcc_id() { return (unsigned)__builtin_amdgcn_s_getreg((3 << 11) | 20) & 0xFu; }
#define XB_SPIN(cond, bar) do { unsigned _sp = 0; while (cond) { __builtin_amdgcn_s_sleep(1); \
    if ((++_sp & 255u) == 0u) { if (xb_ld(&(bar)[XB_TMO])) break; if (_sp > XB_SPIN_CAP) { atomicAdd(&(bar)[XB_TMO], 1u); break; } } } } while (0)

struct XcdBarrier {
    unsigned* bar; unsigned x;
    volatile LAS unsigned* st;
};

__device__ __forceinline__ XcdBarrier xcd_barrier_post(unsigned* bar, volatile LAS unsigned* st) {
    XcdBarrier b; b.bar = bar; b.x = xb_xcc_id(); b.st = st;
    if (threadIdx.x == 0) (void)xb_add(&bar[XB_XCNT(b.x)], 1u);
    return b;
}
__device__ __forceinline__ void xcd_barrier_complete(unsigned* bar, unsigned x, unsigned& nloc, unsigned& nx) {
    const unsigned G = gridDim.x * gridDim.y * gridDim.z;
    unsigned sum, cnt, mine, sp = 0u;
    for (;;) {
        sum = 0u; cnt = 0u; mine = 0u;
#pragma unroll
        for (unsigned j = 0; j < 16; ++j) { const unsigned c = xb_ld(&bar[XB_XCNT(j)]); sum += c; cnt += (c > 0u) ? 1u : 0u; mine = (j == x) ? c : mine; }
        if (sum == G) break;
        __builtin_amdgcn_s_sleep(1);
        if ((++sp & 255u) == 0u) { if (xb_ld(&bar[XB_TMO])) break; if (sp > XB_SPIN_CAP) { atomicAdd(&bar[XB_TMO], 1u); break; } }
    }
    nloc = mine > 0u ? mine : 1u; nx = cnt > 0u ? cnt : 1u;
}

__device__ __forceinline__ void xcd_barrier(const XcdBarrier& b) {
    asm volatile("s_waitcnt vmcnt(0)" ::: "memory");
    __syncthreads();
    if (threadIdx.x == 0) {
        unsigned* bar = b.bar;
        __builtin_amdgcn_s_waitcnt(0);
        unsigned nloc = b.st[0], nx = b.st[1];
        if (nloc == 0u) { xcd_barrier_complete(bar, b.x, nloc, nx); b.st[0] = nloc; b.st[1] = nx; }
        const unsigned old = xb_add(&bar[XB_XSUB(b.x)], 1u);
        const unsigned gen = old / nloc;
        if (old + 1u == (gen + 1u) * nloc) {
            __builtin_amdgcn_fence(__ATOMIC_RELEASE, "agent");
            asm volatile("s_waitcnt vmcnt(0)" ::: "memory");
            const unsigned og = xb_add(&bar[XB_TOP], 1u);
            const unsigned tg = og / nx;
            if (og + 1u == (tg + 1u) * nx) xb_add(&bar[XB_TOPGEN], 1u);
            else XB_SPIN(xb_ld(&bar[XB_TOPGEN]) == tg, bar);
            __builtin_amdgcn_fence(__ATOMIC_ACQUIRE, "agent");
            xb_add(&bar[XB_XGEN(b.x)], 1u);
            asm volatile("s_waitcnt vmcnt(0)" ::: "memory");
        } else {
            XB_SPIN(xb_ld(&bar[XB_XGEN(b.x)]) == gen, bar);
            __builtin_amdgcn_fence(__ATOMIC_ACQUIRE, "agent");
            asm volatile("s_waitcnt vmcnt(0)" ::: "memory");
        }
    }
    __syncthreads();
}

struct EpiSwiGLU {
    static constexpr bool PERM = true, AFTER_DRAIN = false;
    bf16* O;
    DI void operator()(const f32x4 (&acc)[2][2][4][2], const pg8::Unit& u, int wr, int wc, int fr, int fq) const {
        const int row0 = u.pm * 256 + wr * 64 + fr, col0 = u.pn * 128 + wc * 32 + 8 * fq;
#pragma unroll
        for (int ai = 0; ai < 2; ++ai)
#pragma unroll
            for (int m = 0; m < 4; ++m) {
                const f32x4 a0 = acc[ai][0][m][0], a1 = acc[ai][0][m][1], b0 = acc[ai][1][m][0], b1 = acc[ai][1][m][1];
                u32x4 w;
                w.x = pg8::cvt_pk_bf16(silu(a0[0]) * b0[0], silu(a0[1]) * b0[1]); w.y = pg8::cvt_pk_bf16(silu(a0[2]) * b0[2], silu(a0[3]) * b0[3]);
                w.z = pg8::cvt_pk_bf16(silu(a1[0]) * b1[0], silu(a1[1]) * b1[1]); w.w = pg8::cvt_pk_bf16(silu(a1[2]) * b1[2], silu(a1[3]) * b1[3]);
                *(u32x4*)(O + (size_t)(row0 + ai * 128 + m * 16) * FF + col0) = w;
            }
    }
};
struct EpiRes {
    static constexpr bool PERM = false, AFTER_DRAIN = false;
    const float* base; const float* base2; float* out; float alpha; float* SL;
    DI void operator()(const f32x4 (&acc)[2][2][4][2], const pg8::Unit& u, int wr, int wc, int fr, int fq) const {
        const int row0 = u.pm * 256 + wr * 64 + fr, col0 = u.pn * 256 + wc * 32 + 4 * fq;
        const float* bp = (u.pm < 64) ? base : (base2 - (size_t)TP * 1024);
        if (u.split) {
#pragma unroll
            for (int ai = 0; ai < 2; ++ai)
#pragma unroll
                for (int m = 0; m < 4; ++m) { float* op = SL + ((size_t)u.ks * 512 + (size_t)(row0 + ai * 128 + m * 16 - TP)) * 1024 + col0;
#pragma unroll
                    for (int bj = 0; bj < 2; ++bj)
#pragma unroll
                        for (int n = 0; n < 2; ++n) *(f32x4*)(op + bj * 128 + n * 16) = alpha * acc[ai][bj][m][n]; }
            return;
        }
#pragma unroll
        for (int ai = 0; ai < 2; ++ai)
#pragma unroll
            for (int m = 0; m < 4; ++m) {
                const size_t off = (size_t)(row0 + ai * 128 + m * 16) * 1024 + col0;
#pragma unroll
                for (int bj = 0; bj < 2; ++bj)
#pragma unroll
                    for (int n = 0; n < 2; ++n) { const f32x4 b = *(const f32x4*)(bp + off + bj * 128 + n * 16); *(f32x4*)(out + off + bj * 128 + n * 16) = b + alpha * acc[ai][bj][m][n]; }
            }
    }
};
struct EpiProj {
    static constexpr bool PERM = true, AFTER_DRAIN = false;
    bf16* O; float* DT; const float* dtb;
    DI void operator()(const f32x4 (&acc)[2][2][4][2], const pg8::Unit& u, int wr, int wc, int fr, int fq) const {
        const int row0 = u.pm * 256 + wr * 64 + fr;
        if (u.pn < 52) {
            const int col0 = u.pn * 256 + wc * 32 + 8 * fq;
#pragma unroll
            for (int ai = 0; ai < 2; ++ai)
#pragma unroll
                for (int m = 0; m < 4; ++m) { bf16* rowp = O + (size_t)(row0 + ai * 128 + m * 16) * NPROJ + col0;
#pragma unroll
                    for (int bj = 0; bj < 2; ++bj) { const f32x4 v0 = acc[ai][bj][m][0], v1 = acc[ai][bj][m][1]; u32x4 w;
                        w.x = pg8::cvt_pk_bf16(v0[0], v0[1]); w.y = pg8::cvt_pk_bf16(v0[2], v0[3]); w.z = pg8::cvt_pk_bf16(v1[0], v1[1]); w.w = pg8::cvt_pk_bf16(v1[2], v1[3]);
                        *(u32x4*)(rowp + bj * 128) = w; } }
        } else if (wc == 0) {
            const int c0 = 8 * fq;
            const f32x4 bb0 = *(const f32x4*)(dtb + c0), bb1 = *(const f32x4*)(dtb + c0 + 4);
#pragma unroll
            for (int ai = 0; ai < 2; ++ai)
#pragma unroll
                for (int m = 0; m < 4; ++m) { float* rowp = DT + (size_t)(row0 + ai * 128 + m * 16) * 32 + c0;
                    f32x4 v0 = acc[ai][0][m][0] + bb0, v1 = acc[ai][0][m][1] + bb1;
#pragma unroll
                    for (int j = 0; j < 4; ++j) { v0[j] = fmaxf(v0[j], 0.f) + log1pf(expf(-fabsf(v0[j]))); v1[j] = fmaxf(v1[j], 0.f) + log1pf(expf(-fabsf(v1[j]))); }
                    *(f32x4*)rowp = v0; *(f32x4*)(rowp + 4) = v1; }
        }
    }
};
DI void gate_split(const f32x4 (&acc)[2][2][4][2], const pg8::Unit& u, int wr, int wc, int fr, int fq, const bf16* PROJ, int gcol, float* SL, int sbase, const float* SSQ) {
    const int row0 = u.pm * 256 + wr * 64 + fr, col0 = u.pn * 256 + wc * 32 + 8 * fq;
#pragma unroll
    for (int ai = 0; ai < 2; ++ai)
#pragma unroll
        for (int m = 0; m < 4; ++m) { const size_t r = (size_t)(row0 + ai * 128 + m * 16); const float rs = SSQ ? __builtin_amdgcn_rsqf(SSQ[r] * (1.f / 2048.f) + 1e-5f) : 1.f;
#pragma unroll
            for (int bj = 0; bj < 2; ++bj) { const u32x4 gw = *(const u32x4*)(PROJ + r * NPROJ + gcol + col0 + bj * 128);
                const f32x4 v0 = acc[ai][bj][m][0] * rs, v1 = acc[ai][bj][m][1] * rs; float* pp = SL + ((size_t)(sbase + u.ks) * 512 + (r - TP)) * 1024 + col0 + bj * 128; f32x4 o0, o1;
                o0[0] = sigm(bflo(gw.x)) * v0[0]; o0[1] = sigm(bfhi(gw.x)) * v0[1]; o0[2] = sigm(bflo(gw.y)) * v0[2]; o0[3] = sigm(bfhi(gw.y)) * v0[3];
                o1[0] = sigm(bflo(gw.z)) * v1[0]; o1[1] = sigm(bfhi(gw.z)) * v1[1]; o1[2] = sigm(bflo(gw.w)) * v1[2]; o1[3] = sigm(bfhi(gw.w)) * v1[3];
                *(f32x4*)pp = o0; *(f32x4*)(pp + 4) = o1; } }
}
struct EpiGate1 {
    static constexpr bool PERM = true, AFTER_DRAIN = false;
    const bf16* PROJ; float* PART; float* PARTS; const float* SSQ;
    DI void operator()(const f32x4 (&acc)[2][2][4][2], const pg8::Unit& u, int wr, int wc, int fr, int fq) const {
        if (u.split) { gate_split(acc, u, wr, wc, fr, fq, PROJ, PGA, PARTS, 0, SSQ); return; }
        const int row0 = u.pm * 256 + wr * 64 + fr, col0 = u.pn * 256 + wc * 32 + 8 * fq;
#pragma unroll
        for (int ai = 0; ai < 2; ++ai)
#pragma unroll
            for (int m = 0; m < 4; ++m) { const size_t r = (size_t)(row0 + ai * 128 + m * 16); const float rs = __builtin_amdgcn_rsqf(SSQ[r] * (1.f / 2048.f) + 1e-5f);
#pragma unroll
                for (int bj = 0; bj < 2; ++bj) { const u32x4 gw = *(const u32x4*)(PROJ + r * NPROJ + PGA + col0 + bj * 128);
                    const f32x4 v0 = acc[ai][bj][m][0] * rs, v1 = acc[ai][bj][m][1] * rs; f32x4 o0, o1;
                    o0[0] = sigm(bflo(gw.x)) * v0[0]; o0[1] = sigm(bfhi(gw.x)) * v0[1]; o0[2] = sigm(bflo(gw.y)) * v0[2]; o0[3] = sigm(bfhi(gw.y)) * v0[3];
                    o1[0] = sigm(bflo(gw.z)) * v1[0]; o1[1] = sigm(bfhi(gw.z)) * v1[1]; o1[2] = sigm(bflo(gw.w)) * v1[2]; o1[3] = sigm(bfhi(gw.w)) * v1[3];
                    float* pp = PART + r * 1024 + col0 + bj * 128; *(f32x4*)pp = o0; *(f32x4*)(pp + 4) = o1; } }
    }
};
struct EpiGate2 {
    static constexpr bool PERM = true, AFTER_DRAIN = false;
    const bf16* PROJ; const float* PART; bf16* O; float* PARTS;
    DI void operator()(const f32x4 (&acc)[2][2][4][2], const pg8::Unit& u, int wr, int wc, int fr, int fq) const {
        if (u.split) { gate_split(acc, u, wr, wc, fr, fq, PROJ, PGB, PARTS, 8, nullptr); return; }
        const int row0 = u.pm * 256 + wr * 64 + fr, col0 = u.pn * 256 + wc * 32 + 8 * fq;
#pragma unroll
        for (int ai = 0; ai < 2; ++ai)
#pragma unroll
            for (int m = 0; m < 4; ++m) { const size_t r = (size_t)(row0 + ai * 128 + m * 16);
#pragma unroll
                for (int bj = 0; bj < 2; ++bj) { const u32x4 gw = *(const u32x4*)(PROJ + r * NPROJ + PGB + col0 + bj * 128);
                    const float* pp = PART + r * 1024 + col0 + bj * 128; const f32x4 p0 = *(const f32x4*)pp, p1 = *(const f32x4*)(pp + 4);
                    const f32x4 v0 = acc[ai][bj][m][0], v1 = acc[ai][bj][m][1]; u32x4 w;
                    w.x = pg8::cvt_pk_bf16(p0[0] + sigm(bflo(gw.x)) * v0[0], p0[1] + sigm(bfhi(gw.x)) * v0[1]);
                    w.y = pg8::cvt_pk_bf16(p0[2] + sigm(bflo(gw.y)) * v0[2], p0[3] + sigm(bfhi(gw.y)) * v0[3]);
                    w.z = pg8::cvt_pk_bf16(p1[0] + sigm(bflo(gw.z)) * v1[0], p1[1] + sigm(bfhi(gw.z)) * v1[1]);
                    w.w = pg8::cvt_pk_bf16(p1[2] + sigm(bflo(gw.w)) * v1[2], p1[3] + sigm(bfhi(gw.w)) * v1[3]);
                    *(u32x4*)(O + r * 1024 + col0 + bj * 128) = w; } }
    }
};

DI void pack_item64(const float* W, int ldw, int col0a, int col0b, float scale, bool zeroa, bool zerob, bf16* WT, int K, int nrow0, int k0, LAS float* scr, int lane, const float* gk) {
    const int half = (lane >> 3) & 1, c4 = (lane & 7) * 4, kr = lane >> 4;
    const int colsrc = (half ? col0b : col0a) + c4; const bool zr = half ? zerob : zeroa;
    f32x4 v[16];
    const float* wp = W + (size_t)(k0 + kr) * ldw + colsrc;
#pragma unroll
    for (int i = 0; i < 16; ++i) v[i] = zr ? (f32x4){0.f, 0.f, 0.f, 0.f} : __builtin_nontemporal_load((const f32x4*)(wp + (size_t)(4 * i) * ldw));
#pragma unroll
    for (int i = 0; i < 16; ++i) { LAS float* d = scr + (4 * i + kr) * 65 + 32 * half + c4; d[0] = v[i][0] * scale; d[1] = v[i][1] * scale; d[2] = v[i][2] * scale; d[3] = v[i][3] * scale; }
    LDS_WAIT();
    const int c = lane & 7;
    f32x4 g0 = (f32x4){1.f, 1.f, 1.f, 1.f}, g1 = g0;
    if (gk) { g0 = *(const f32x4*)(gk + k0 + 8 * c); g1 = *(const f32x4*)(gk + k0 + 8 * c + 4); }
#pragma unroll
    for (int j = 0; j < 8; ++j) { const int n = (lane >> 3) + 8 * j; const LAS float* s = scr + (8 * c) * 65 + n;
        u32x4 o; o.x = pk2(s[0 * 65] * g0[0], s[1 * 65] * g0[1]); o.y = pk2(s[2 * 65] * g0[2], s[3 * 65] * g0[3]); o.z = pk2(s[4 * 65] * g1[0], s[5 * 65] * g1[1]); o.w = pk2(s[6 * 65] * g1[2], s[7 * 65] * g1[3]);
        *(u32x4*)(WT + (size_t)(nrow0 + n) * K + k0 + 8 * c) = o; }
    LDS_WAIT();
}
template <int NR> DI void rms_rows_bf16(const float* const (&xr)[NR], const bool (&ok)[NR], const float* g, bf16* const (&orow)[NR], int lane, float eps) {
    f32x4 v[NR][4];
#pragma unroll
    for (int r = 0; r < NR; ++r)
#pragma unroll
        for (int j = 0; j < 4; ++j) v[r][j] = *((const f32x4*)xr[r] + lane + 64 * j);
    f32x4 gg[4];
#pragma unroll
    for (int j = 0; j < 4; ++j) gg[j] = *((const f32x4*)g + lane + 64 * j);
#pragma unroll
    for (int r = 0; r < NR; ++r) { float s = 0.f;
#pragma unroll
        for (int j = 0; j < 4; ++j) s += (v[r][j][0] * v[r][j][0] + v[r][j][1] * v[r][j][1]) + (v[r][j][2] * v[r][j][2] + v[r][j][3] * v[r][j][3]);
        const float rstd = __builtin_amdgcn_rsqf(wave_sum(s) * (1.f / 1024.f) + eps);
        if (ok[r]) {
#pragma unroll
            for (int j = 0; j < 4; ++j) { u32x2 o; o.x = pk2(v[r][j][0] * rstd * gg[j][0], v[r][j][1] * rstd * gg[j][1]); o.y = pk2(v[r][j][2] * rstd * gg[j][2], v[r][j][3] * rstd * gg[j][3]); *((u32x2*)orow[r] + lane + 64 * j) = o; } } }
}

DI void phase_rms(float* X, const float* g, bf16* O, int G, const float* base_s, const float* SL, int ns) {
    int tid_ = threadIdx.x; asm volatile("" : "+v"(tid_)); const int lane = tid_ & 63, gw = blockIdx.x * NWV + (tid_ >> 6), NGW = G * NWV;
    for (int m = gw; m < TP; m += 4 * NGW) { const float* xr[4]; bf16* orow[4]; bool ok[4];
#pragma unroll
        for (int r = 0; r < 4; ++r) { const int mr = m + r * NGW; ok[r] = mr < TP; const int mc = ok[r] ? mr : m; xr[r] = X + (size_t)mc * 1024; orow[r] = O + (size_t)mc * 1024; }
        rms_rows_bf16<4>(xr, ok, g, orow, lane, 1e-6f); }
    for (int r = gw; r < 512; r += NGW) {
        f32x4 v[4]; float s = 0.f;
#pragma unroll
        for (int j = 0; j < 4; ++j) v[j] = *((const f32x4*)(base_s + (size_t)r * 1024) + lane + 64 * j);
        for (int k = 0; k < ns; ++k) {
#pragma unroll
            for (int j = 0; j < 4; ++j) v[j] += *((const f32x4*)(SL + ((size_t)k * 512 + r) * 1024) + lane + 64 * j); }
        float* xr = X + (size_t)(TP + r) * 1024;
#pragma unroll
        for (int j = 0; j < 4; ++j) { *((f32x4*)xr + lane + 64 * j) = v[j]; s += (v[j][0] * v[j][0] + v[j][1] * v[j][1]) + (v[j][2] * v[j][2] + v[j][3] * v[j][3]); }
        const float rstd = 1.f / sqrtf(wave_sum(s) * (1.f / 1024.f) + 1e-6f);
#pragma unroll
        for (int j = 0; j < 4; ++j) { const f32x4 gg = *((const f32x4*)g + lane + 64 * j); u32x2 o; o.x = pk2(v[j][0] * rstd * gg[0], v[j][1] * rstd * gg[1]); o.y = pk2(v[j][2] * rstd * gg[2], v[j][3] * rstd * gg[3]);
            *((u32x2*)(O + (size_t)(TP + r) * 1024) + lane + 64 * j) = o; }
    }
}

DI void phase0(const Params& p, LAS unsigned char* lds, int G, int pmask) {
    unsigned char* ws = p.ws;
    int tid_ = threadIdx.x; asm volatile("" : "+v"(tid_)); const int tid = tid_, lane = tid & 63, w = tid >> 6;
    const int gw = blockIdx.x * NWV + w, NGW = G * NWV;
    LAS float* scr = (LAS float*)(lds + w * 16640);
    if (pmask & 1) for (int it = gw; it < 8896; it += NGW) {
        const float* src; int ldw, cola, colb, K, nb, kb; float scale = 1.f; bool za = false, zb = false; bf16* WT; const float* gk = nullptr;
        if (it < 2816) { const int mat = it / 1408, r = it % 1408; kb = r / 88; nb = r % 88; const int pn = nb >> 2, wi = nb & 3;
            src = p.in[mat ? (wi < 2 ? I_F2W1 : I_F2W3) : (wi < 2 ? I_F1W1 : I_F1W3)]; ldw = FF; cola = 128 * pn + 64 * (wi & 1); colb = cola + 32; K = 1024; WT = (bf16*)(ws + (mat ? WS_W13B : WS_W13A)); }
        else if (it < 4224) { int r = it - 2816; const int mat = r / 704; r %= 704; kb = r / 16; nb = r % 16; src = p.in[mat ? I_F2W2 : I_F1W2]; ldw = 1024; cola = 64 * nb; colb = cola + 32; K = FF; WT = (bf16*)(ws + (mat ? WS_W2B : WS_W2A)); }
        else if (it < 7616) { const int r = it - 4224; kb = r / 212; nb = r % 212; const int pca = 64 * nb, pcb = pca + 32; za = pca >= 13344; zb = pcb >= 13344;
            cola = pca < 5120 ? pca : (pca < 13312 ? pca + 32 : 5120); colb = pcb < 5120 ? pcb : (pcb < 13312 ? pcb + 32 : 5120); if (za) cola = 0; if (zb) colb = 0;
            scale = (pca >= PK && pca < PV) ? 0.0625f : 1.f; src = p.in[I_WIN]; ldw = 13344; K = 1024; WT = (bf16*)(ws + WS_WIN); }
        else if (it < 8640) { int r = it - 7616; const int mat = r / 512; r %= 512; kb = r / 16; nb = r % 16; src = p.in[mat ? I_WBR : I_WBS]; gk = mat ? nullptr : p.in[I_SSMN]; ldw = 1024; cola = 64 * nb; colb = cola + 32; K = 2048; WT = (bf16*)(ws + (mat ? WS_WBR : WS_WBS)); }
        else { const int r = it - 8640; kb = r / 16; nb = r % 16; src = p.in[I_WO]; ldw = 1024; cola = 64 * nb; colb = cola + 32; K = 1024; WT = (bf16*)(ws + WS_WO); }
        pack_item64(src, ldw, cola, colb, scale, za, zb, WT, K, 64 * nb, 64 * kb, scr, lane, gk);
    }
    if (pmask & 2) for (int m = gw; m < T; m += 4 * NGW) { const float* xr[4]; bf16* orow[4]; bool ok[4];
#pragma unroll
        for (int r = 0; r < 4; ++r) { const int mr = m + r * NGW; ok[r] = mr < T; const int mc = ok[r] ? mr : m;
            xr[r] = (mc < TP) ? p.in[I_XP] + (size_t)mc * 1024 : p.in[I_XS] + (size_t)(mc - TP) * 1024; orow[r] = (bf16*)(ws + WS_XN) + (size_t)mc * 1024; }
        rms_rows_bf16<4>(xr, ok, p.in[I_NF1], orow, lane, 1e-6f); }
    const int gt = blockIdx.x * NTHR + tid, NGT = G * NTHR;
    float* rope = (float*)(ws + WS_ROPE);
    if (pmask & 4) for (int e = gt; e < 2052 * 128; e += NGT) { const int pi = e >> 7, i = e & 127; const double pos = (double)(pi < 2048 ? pi : 16384 + (pi - 2048));
        const double inv = exp(-(double)i * (9.210340371976184 / 128.0)); const double rev = pos * inv * 0.15915494309189535; const double fr = rev - rint(rev);
        const h2_t cs = {(_Float16)__builtin_amdgcn_cosf((float)fr), (_Float16)__builtin_amdgcn_sinf((float)fr)}; ((unsigned*)rope)[e] = __builtin_bit_cast(unsigned, cs); }
    float* ssq = (float*)(ws + WS_SSQS);
    for (int e = gt; e < T; e += NGT) ssq[e] = 0.f;
    float* ssr = (float*)(ws + WS_SSQR);
    for (int e = gt; e < 4 * T; e += NGT) ssr[e] = 0.f;
}

DI void unpack8(const u32x4 a, float (&o)[8]) { o[0] = bflo(a.x); o[1] = bfhi(a.x); o[2] = bflo(a.y); o[3] = bfhi(a.y); o[4] = bflo(a.z); o[5] = bfhi(a.z); o[6] = bflo(a.w); o[7] = bfhi(a.w); }
DI void phase_conv(const Params& p, int G) {
    const bf16* PROJ = (const bf16*)(p.ws + WS_PROJ); bf16* XB = (bf16*)(p.ws + WS_XBCC);
    const float* cw = p.in[I_CONVW]; const float* cb = p.in[I_CONVB];
    int tid_ = threadIdx.x; asm volatile("" : "+v"(tid_));
    const int gt = blockIdx.x * NTHR + tid_, NGT = G * NTHR;
    for (int u = gt; u < 1024 * 384; u += NGT) {
        const int seg = u / 384, cgp = u % 384, c0 = 8 * cgp, row0 = 16 * seg, tseq0 = row0 & (SEQ - 1);
        u32x4 raw[19];
        const bf16* src = PROJ + (size_t)row0 * NPROJ + PXBC + c0;
#pragma unroll
        for (int i = 0; i < 19; ++i) { if (i >= 3 || tseq0 != 0) raw[i] = __builtin_nontemporal_load((const u32x4*)(src + (ptrdiff_t)(i - 3) * NPROJ)); else raw[i] = (u32x4){0u, 0u, 0u, 0u}; }
        float wk[4][8], bb[8];
#pragma unroll
        for (int k = 0; k < 4; ++k) { const f32x4 a = *(const f32x4*)(cw + k * 3072 + c0), b = *(const f32x4*)(cw + k * 3072 + c0 + 4);
#pragma unroll
            for (int j = 0; j < 4; ++j) { wk[k][j] = a[j]; wk[k][4 + j] = b[j]; } }
        { const f32x4 a = *(const f32x4*)(cb + c0), b = *(const f32x4*)(cb + c0 + 4);
#pragma unroll
          for (int j = 0; j < 4; ++j) { bb[j] = a[j]; bb[4 + j] = b[j]; } }
        float r0[8], r1[8], r2[8];
        unpack8(raw[0], r0); unpack8(raw[1], r1); unpack8(raw[2], r2);
#pragma unroll
        for (int i = 0; i < 16; ++i) {
            float cur[8], o[8]; unpack8(raw[i + 3], cur);
#pragma unroll
            for (int j = 0; j < 8; ++j) { o[j] = silu(bb[j] + wk[0][j] * r0[j] + wk[1][j] * r1[j] + wk[2][j] * r2[j] + wk[3][j] * cur[j]); r0[j] = r1[j]; r1[j] = r2[j]; r2[j] = cur[j]; }
            u32x4 w; w.x = pk2(o[0], o[1]); w.y = pk2(o[2], o[3]); w.z = pk2(o[4], o[5]); w.w = pk2(o[6], o[7]);
            *(u32x4*)(XB + (size_t)(row0 + i) * 3072 + c0) = w;
            if (i >= 13 && tseq0 == SEQ - 16) { float* dst = p.out + O_CONVP + ((size_t)(row0 >> 11) * 3 + (i - 13)) * 3072 + c0;
                *(f32x4*)dst = (f32x4){cur[0], cur[1], cur[2], cur[3]}; *(f32x4*)(dst + 4) = (f32x4){cur[4], cur[5], cur[6], cur[7]}; }
        }
    }
    for (int u = gt; u < 128 * 384; u += NGT) {
        const int seg = u / 384, cgp = u % 384, c0 = 8 * cgp, row0 = TP + 4 * seg;
        u32x4 raw[4];
#pragma unroll
        for (int i = 0; i < 4; ++i) raw[i] = *(const u32x4*)(PROJ + (size_t)(row0 + i) * NPROJ + PXBC + c0);
        float wk[4][8], bb[8], r0[8], r1[8], r2[8];
#pragma unroll
        for (int k = 0; k < 4; ++k) { const f32x4 a = *(const f32x4*)(cw + k * 3072 + c0), b = *(const f32x4*)(cw + k * 3072 + c0 + 4);
#pragma unroll
            for (int j = 0; j < 4; ++j) { wk[k][j] = a[j]; wk[k][4 + j] = b[j]; } }
        { const f32x4 a = *(const f32x4*)(cb + c0), b = *(const f32x4*)(cb + c0 + 4);
#pragma unroll
          for (int j = 0; j < 4; ++j) { bb[j] = a[j]; bb[4 + j] = b[j]; } }
        const float* st = p.in[I_SCONV] + (size_t)seg * 3 * 3072 + c0;
#pragma unroll
        for (int j = 0; j < 8; ++j) { r0[j] = st[j]; r1[j] = st[3072 + j]; r2[j] = st[2 * 3072 + j]; }
#pragma unroll
        for (int i = 0; i < 4; ++i) {
            float cur[8], o[8]; unpack8(raw[i], cur);
#pragma unroll
            for (int j = 0; j < 8; ++j) { o[j] = silu(bb[j] + wk[0][j] * r0[j] + wk[1][j] * r1[j] + wk[2][j] * r2[j] + wk[3][j] * cur[j]); r0[j] = r1[j]; r1[j] = r2[j]; r2[j] = cur[j]; }
            u32x4 w; w.x = pk2(o[0], o[1]); w.y = pk2(o[2], o[3]); w.z = pk2(o[4], o[5]); w.w = pk2(o[6], o[7]);
            *(u32x4*)(XB + (size_t)(row0 + i) * 3072 + c0) = w;
            if (i >= 1) { float* dst = p.out + O_CONVS + ((size_t)seg * 3 + (i - 1)) * 3072 + c0;
                *(f32x4*)dst = (f32x4){cur[0], cur[1], cur[2], cur[3]}; *(f32x4*)(dst + 4) = (f32x4){cur[4], cur[5], cur[6], cur[7]}; }
        }
    }
}

DI void ssd_prompt_item(const Params& p, LAS unsigned char* lds, int b, int h, int pass) {
    int tid_ = threadIdx.x; asm volatile("" : "+v"(tid_)); const int tid = tid_, lane = tid & 63, w = tid >> 6, fr = lane & 15, fq = lane >> 4, tr = w >> 1, wc2 = w & 1, g = h >> 3;
    const bf16* XB = (const bf16*)(p.ws + WS_XBCC); const bf16* PROJ = (const bf16*)(p.ws + WS_PROJ); const float* DT = (const float*)(p.ws + WS_DT);
    bf16* Y = (bf16*)(p.ws + WS_Y); float* SSQ = (float*)(p.ws + (pass ? WS_DUM : WS_SSQS));
    LAS unsigned char* Cs = lds; LAS unsigned char* Bs = lds + 17408; LAS unsigned char* BTs = lds + 34816; LAS unsigned char* XT = lds + 53248;
    LAS unsigned char* Ws = lds + 62464; LAS unsigned char* Hb = lds + 71680; LAS float* fla = (LAS float*)(lds + 89088); LAS float* fdt = fla + 64;
    const float a = -expf(p.in[I_ALOG][h]), Dh = p.in[I_SSMD][h];
    for (int i = tid; i < 17408 / 4; i += NTHR) ((LAS unsigned*)Hb)[i] = 0u;
    f32x4 Hacc[4];
#pragma unroll
    for (int i = 0; i < 4; ++i) Hacc[i] = (f32x4){0.f, 0.f, 0.f, 0.f};
    u32x4 pvb[2], pvc[2], pvx, pvz; float pdt;
    const unsigned so_b0 = (unsigned)(((tid >> 4) * 3072 + 2048 + 128 * g + 8 * (tid & 15)) * 2), so_b1 = so_b0 + 32u * 3072u * 2u, so_x = (unsigned)(((tid >> 3) * 3072 + 64 * h + 8 * (tid & 7)) * 2), so_dt = (unsigned)((lane * 32 + h) * 4);
    LAS unsigned char* Xs = lds + 89600;
    LAS unsigned char* Zs = lds + 98816;
    const unsigned so_z = (unsigned)(((tid >> 3) * NPROJ + PZ + 64 * h + 8 * (tid & 7)) * 2);
#define SSD_LOAD(stp) do { const char* xb_ = (const char*)XB + (size_t)(b * SEQ + (stp) * 64) * 3072 * 2; const char* dt_ = (const char*)DT + (size_t)(b * SEQ + (stp) * 64) * 32 * 4; \
        pdt = *(const float*)(dt_ + so_dt); pvb[0] = *(const u32x4*)(xb_ + so_b0); pvc[0] = *(const u32x4*)(xb_ + so_b0 + 1024); pvb[1] = *(const u32x4*)(xb_ + so_b1); pvc[1] = *(const u32x4*)(xb_ + so_b1 + 1024); \
        pvx = *(const u32x4*)(xb_ + so_x); pvz = *(const u32x4*)((const char*)PROJ + (size_t)(b * SEQ + (stp) * 64) * NPROJ * 2 + so_z); } while (0)
    SSD_LOAD(0);
    for (int step = 0; step < 32; ++step) {
        const int R0 = b * SEQ + step * 64;
        const float dtv = pdt;
        float la = dtv * a;
#pragma unroll
        for (int o = 1; o < 64; o <<= 1) { const float t = __shfl_up(la, o); if (lane >= o) la += t; }
        const float la_end = __shfl(la, 63);
        const float tail = __expf(la_end - la) * dtv;
        if (w == 0) { fla[lane] = la; fdt[lane] = dtv; }
#pragma unroll
        for (int i = 0; i < 2; ++i) { const int r = (tid >> 4) + 32 * i, ch = tid & 15;
            *(LAS u32x4*)(Cs + r * 272 + ch * 16) = pvc[i]; *(LAS u32x4*)(Bs + r * 272 + ch * 16) = pvb[i]; }
        { const int r = tid >> 3, ch = tid & 7; *(LAS u32x4*)(Xs + r * 144 + ch * 16) = pvx; *(LAS u32x4*)(Zs + r * 144 + ch * 16) = pvz; }
        LBAR();
#pragma unroll
        for (int i = 0; i < 2; ++i) { const int r = lane, ch = w + 8 * i;
            const u32x4 vb = *(const LAS u32x4*)(Bs + r * 272 + ch * 16); const float tl = tail;
            LAS unsigned short* bt = (LAS unsigned short*)(BTs + (8 * ch) * 144 + r * 2);
            const unsigned w0 = pk2(bflo(vb.x) * tl, bfhi(vb.x) * tl), w1 = pk2(bflo(vb.y) * tl, bfhi(vb.y) * tl), w2 = pk2(bflo(vb.z) * tl, bfhi(vb.z) * tl), w3 = pk2(bflo(vb.w) * tl, bfhi(vb.w) * tl);
            bt[0 * 72] = (unsigned short)w0; bt[1 * 72] = (unsigned short)(w0 >> 16); bt[2 * 72] = (unsigned short)w1; bt[3 * 72] = (unsigned short)(w1 >> 16);
            bt[4 * 72] = (unsigned short)w2; bt[5 * 72] = (unsigned short)(w2 >> 16); bt[6 * 72] = (unsigned short)w3; bt[7 * 72] = (unsigned short)(w3 >> 16); }
        { const int r = lane, ch = w; const u32x4 vx = *(const LAS u32x4*)(Xs + r * 144 + ch * 16);
            LAS unsigned short* xt = (LAS unsigned short*)(XT + (8 * ch) * 144 + r * 2);
            xt[0 * 72] = (unsigned short)(vx.x & 0xffffu); xt[1 * 72] = (unsigned short)(vx.x >> 16); xt[2 * 72] = (unsigned short)(vx.y & 0xffffu); xt[3 * 72] = (unsigned short)(vx.y >> 16);
            xt[4 * 72] = (unsigned short)(vx.z & 0xffffu); xt[5 * 72] = (unsigned short)(vx.z >> 16); xt[6 * 72] = (unsigned short)(vx.w & 0xffffu); xt[7 * 72] = (unsigned short)(vx.w >> 16); }
        if (step + 1 < 32) SSD_LOAD(step + 1);
        const int t = 16 * tr + fr; const float lat = fla[t];
        {
            f32x4 G0 = (f32x4){0.f, 0.f, 0.f, 0.f}, G1 = G0;
            bf16x8 fa[4], fb0[4], fb1[4];
#pragma unroll
            for (int ks = 0; ks < 4; ++ks) { fa[ks] = ldsfrag(Cs + t * 272 + (32 * ks + 8 * fq) * 2); fb0[ks] = ldsfrag(Bs + (32 * wc2 + fr) * 272 + (32 * ks + 8 * fq) * 2); fb1[ks] = ldsfrag(Bs + (32 * wc2 + 16 + fr) * 272 + (32 * ks + 8 * fq) * 2); }
            __builtin_amdgcn_sched_barrier(0);
#pragma unroll
            for (int ks = 0; ks < 4; ++ks) { G0 = mfma16(fb0[ks], fa[ks], G0); G1 = mfma16(fb1[ks], fa[ks], G1); }
            float wv[8];
#pragma unroll
            for (int j = 0; j < 8; ++j) { const int s = 32 * wc2 + 16 * (j >> 2) + 4 * fq + (j & 3); const float gv = (j < 4) ? G0[j & 3] : G1[j & 3];
                wv[j] = (s <= t) ? gv * __expf(lat - fla[s]) * fdt[s] : 0.f; }
            u32x2 o0, o1; o0.x = pk2(wv[0], wv[1]); o0.y = pk2(wv[2], wv[3]); o1.x = pk2(wv[4], wv[5]); o1.y = pk2(wv[6], wv[7]);
            *(LAS u32x2*)(Ws + t * 144 + (32 * wc2 + 4 * fq) * 2) = o0; *(LAS u32x2*)(Ws + t * 144 + (32 * wc2 + 16 + 4 * fq) * 2) = o1;
        }
        LBAR();
        {
            f32x4 Y1a = (f32x4){0.f, 0.f, 0.f, 0.f}, Y1b = Y1a, Y2a = Y1a, Y2b = Y1a;
            {
            bf16x8 wa[2], wx0[2], wx1[2], ca[4], hb0[4], hb1[4];
#pragma unroll
            for (int ks = 0; ks < 2; ++ks) { wa[ks] = ldsfrag(Ws + t * 144 + (32 * ks + 8 * fq) * 2); wx0[ks] = ldsfrag(XT + (32 * wc2 + fr) * 144 + (32 * ks + 8 * fq) * 2); wx1[ks] = ldsfrag(XT + (32 * wc2 + 16 + fr) * 144 + (32 * ks + 8 * fq) * 2); }
#pragma unroll
            for (int ks = 0; ks < 4; ++ks) { ca[ks] = ldsfrag(Cs + t * 272 + (32 * ks + 8 * fq) * 2); hb0[ks] = ldsfrag(Hb + (32 * wc2 + fr) * 272 + (32 * ks + 8 * fq) * 2); hb1[ks] = ldsfrag(Hb + (32 * wc2 + 16 + fr) * 272 + (32 * ks + 8 * fq) * 2); }
            __builtin_amdgcn_sched_barrier(0);
#pragma unroll
            for (int ks = 0; ks < 2; ++ks) { Y1a = mfma16(wx0[ks], wa[ks], Y1a); Y1b = mfma16(wx1[ks], wa[ks], Y1b); }
#pragma unroll
            for (int ks = 0; ks < 4; ++ks) { Y2a = mfma16(hb0[ks], ca[ks], Y2a); Y2b = mfma16(hb1[ks], ca[ks], Y2b); }
            }
            const float el = __expf(lat); const size_t row = (size_t)(R0 + t); float ss = 0.f;
#pragma unroll
            for (int tl = 0; tl < 2; ++tl) { const int pc = 64 * h + 32 * wc2 + 16 * tl + 4 * fq; const f32x4 y1 = tl ? Y1b : Y1a, y2 = tl ? Y2b : Y2a;
                const int pl = (32 * wc2 + 16 * tl + 4 * fq) * 2; const u32x2 xv = *(const LAS u32x2*)(Xs + t * 144 + pl), zv = *(const LAS u32x2*)(Zs + t * 144 + pl);
                const float v0 = (y1[0] + el * y2[0] + Dh * bflo(xv.x)) * silu(bflo(zv.x)), v1 = (y1[1] + el * y2[1] + Dh * bfhi(xv.x)) * silu(bfhi(zv.x));
                const float v2 = (y1[2] + el * y2[2] + Dh * bflo(xv.y)) * silu(bflo(zv.y)), v3 = (y1[3] + el * y2[3] + Dh * bfhi(xv.y)) * silu(bfhi(zv.y));
                ss += (v0 * v0 + v1 * v1) + (v2 * v2 + v3 * v3);
                u32x2 o; o.x = pk2(v0, v1); o.y = pk2(v2, v3); *(u32x2*)(Y + row * 4096 + pc) = o; }
            ss += __shfl_xor(ss, 16); ss += __shfl_xor(ss, 32);
            if (fq == 0) atomicAdd(SSQ + row, ss);
        }
        {
            const float dec = __expf(la_end);
#pragma unroll
            for (int i = 0; i < 4; ++i) Hacc[i] = Hacc[i] * dec;
            bf16x8 xa[2], bt[2][4];
#pragma unroll
            for (int ks = 0; ks < 2; ++ks) { xa[ks] = ldsfrag(XT + t * 144 + (32 * ks + 8 * fq) * 2);
#pragma unroll
                for (int i = 0; i < 4; ++i) bt[ks][i] = ldsfrag(BTs + (64 * wc2 + 16 * i + fr) * 144 + (32 * ks + 8 * fq) * 2); }
            __builtin_amdgcn_sched_barrier(0);
#pragma unroll
            for (int ks = 0; ks < 2; ++ks)
#pragma unroll
                for (int i = 0; i < 4; ++i) Hacc[i] = mfma16(bt[ks][i], xa[ks], Hacc[i]);
        }
        LBAR();
#pragma unroll
        for (int i = 0; i < 4; ++i) { u32x2 o; o.x = pk2(Hacc[i][0], Hacc[i][1]); o.y = pk2(Hacc[i][2], Hacc[i][3]); *(LAS u32x2*)(Hb + t * 272 + (64 * wc2 + 16 * i + 4 * fq) * 2) = o; }
    }
    float* hs = p.out + O_SSMP + ((size_t)(b * 32 + h) * 64 + 16 * tr + fr) * 128 + 64 * wc2 + 4 * fq;
#pragma unroll
    for (int i = 0; i < 4; ++i) *(f32x4*)(hs + 16 * i) = Hacc[i];
    LBAR();
}

DI void ret_prompt_item(const Params& p, LAS unsigned char* lds, int b, int h, int vs, int pass) {
    int tid_ = threadIdx.x; asm volatile("" : "+v"(tid_)); const int tid = tid_, lane = tid & 63, w = tid >> 6, fr = lane & 15, fq = lane >> 4, tr = w >> 1, wc2 = w & 1, e0 = 64 * vs;
    const bf16* PROJ = (const bf16*)(p.ws + WS_PROJ); const float* ROPE = (const float*)(p.ws + WS_ROPE);
    bf16* Y = (bf16*)(p.ws + WS_Y); float* SSQ = (float*)(p.ws + (pass ? WS_DUM + (size_t)T * 4 : WS_SSQR));
    LAS unsigned char* Qs = lds; LAS unsigned char* Ks = lds + 33792; LAS unsigned char* KTs = lds + 67584; LAS unsigned char* VT = lds + 104448;
    LAS unsigned char* Ss = lds + 113664; LAS unsigned char* HTb = lds + 122880;
    const float lg = log1pf(-exp2f(-5.f - (float)h));
    for (int i = tid; i < 33792 / 4; i += NTHR) ((LAS unsigned*)HTb)[i] = 0u;
    f32x4 HT[8];
#pragma unroll
    for (int i = 0; i < 8; ++i) HT[i] = (f32x4){0.f, 0.f, 0.f, 0.f};
    const int t = 16 * tr + fr;
    u32x4 rq1[2], rq2[2], rk1[2], rk2[2], pvx, pr0[2], pr1[2];
    const unsigned ro_q0 = (unsigned)(((tid >> 4) * NPROJ + PQ + 256 * h + 8 * (tid & 15)) * 2), ro_q1 = ro_q0 + 32u * (unsigned)NPROJ * 2u, ro_v = (unsigned)(((tid >> 3) * NPROJ + PV + 512 * h + e0 + 8 * (tid & 7)) * 2);
    const unsigned ro_r0 = (unsigned)(((tid >> 4) * 128 + 8 * (tid & 15)) * 4), ro_r1 = ro_r0 + 32u * 128u * 4u;
#define RET_LOAD(stp) do { const char* pj_ = (const char*)PROJ + (size_t)(b * SEQ + (stp) * 64) * NPROJ * 2; \
        rq1[0] = *(const u32x4*)(pj_ + ro_q0); rq2[0] = *(const u32x4*)(pj_ + ro_q0 + 256); rk1[0] = *(const u32x4*)(pj_ + ro_q0 + 2048); rk2[0] = *(const u32x4*)(pj_ + ro_q0 + 2304); \
        rq1[1] = *(const u32x4*)(pj_ + ro_q1); rq2[1] = *(const u32x4*)(pj_ + ro_q1 + 256); rk1[1] = *(const u32x4*)(pj_ + ro_q1 + 2048); rk2[1] = *(const u32x4*)(pj_ + ro_q1 + 2304); \
        { const char* rp_ = (const char*)ROPE + (size_t)((stp) * 64) * 128 * 4; pr0[0] = *(const u32x4*)(rp_ + ro_r0); pr1[0] = *(const u32x4*)(rp_ + ro_r0 + 16); pr0[1] = *(const u32x4*)(rp_ + ro_r1); pr1[1] = *(const u32x4*)(rp_ + ro_r1 + 16); } \
        pvx = *(const u32x4*)(pj_ + ro_v); } while (0)
    RET_LOAD(0);
    for (int step = 0; step < 32; ++step) {
        const int R0 = b * SEQ + step * 64;
#pragma unroll
        for (int i = 0; i < 2; ++i) { const int r = (tid >> 4) + 32 * i, ig = tid & 15;
            const u32x4 q1 = rq1[i], q2 = rq2[i], k1 = rk1[i], k2 = rk2[i];
            const u32x4 ra = pr0[i], rb = pr1[i];
            float qa[8], qb[8], ka[8], kb[8], cc[8], sn[8];
            qa[0] = bflo(q1.x); qa[1] = bfhi(q1.x); qa[2] = bflo(q1.y); qa[3] = bfhi(q1.y); qa[4] = bflo(q1.z); qa[5] = bfhi(q1.z); qa[6] = bflo(q1.w); qa[7] = bfhi(q1.w);
            qb[0] = bflo(q2.x); qb[1] = bfhi(q2.x); qb[2] = bflo(q2.y); qb[3] = bfhi(q2.y); qb[4] = bflo(q2.z); qb[5] = bfhi(q2.z); qb[6] = bflo(q2.w); qb[7] = bfhi(q2.w);
            ka[0] = bflo(k1.x); ka[1] = bfhi(k1.x); ka[2] = bflo(k1.y); ka[3] = bfhi(k1.y); ka[4] = bflo(k1.z); ka[5] = bfhi(k1.z); ka[6] = bflo(k1.w); ka[7] = bfhi(k1.w);
            kb[0] = bflo(k2.x); kb[1] = bfhi(k2.x); kb[2] = bflo(k2.y); kb[3] = bfhi(k2.y); kb[4] = bflo(k2.z); kb[5] = bfhi(k2.z); kb[6] = bflo(k2.w); kb[7] = bfhi(k2.w);
            cc[0] = h2lo(ra.x); sn[0] = h2hi(ra.x); cc[1] = h2lo(ra.y); sn[1] = h2hi(ra.y); cc[2] = h2lo(ra.z); sn[2] = h2hi(ra.z); cc[3] = h2lo(ra.w); sn[3] = h2hi(ra.w);
            cc[4] = h2lo(rb.x); sn[4] = h2hi(rb.x); cc[5] = h2lo(rb.y); sn[5] = h2hi(rb.y); cc[6] = h2lo(rb.z); sn[6] = h2hi(rb.z); cc[7] = h2lo(rb.w); sn[7] = h2hi(rb.w);
            float oq1[8], oq2[8], ok1[8], ok2[8];
#pragma unroll
            for (int j = 0; j < 8; ++j) { oq1[j] = qa[j] * cc[j] - qb[j] * sn[j]; oq2[j] = qa[j] * sn[j] + qb[j] * cc[j]; ok1[j] = ka[j] * cc[j] - kb[j] * sn[j]; ok2[j] = ka[j] * sn[j] + kb[j] * cc[j]; }
            u32x4 o;
            o.x = pk2(oq1[0], oq1[1]); o.y = pk2(oq1[2], oq1[3]); o.z = pk2(oq1[4], oq1[5]); o.w = pk2(oq1[6], oq1[7]); *(LAS u32x4*)(Qs + r * 528 + ig * 16) = o;
            o.x = pk2(oq2[0], oq2[1]); o.y = pk2(oq2[2], oq2[3]); o.z = pk2(oq2[4], oq2[5]); o.w = pk2(oq2[6], oq2[7]); *(LAS u32x4*)(Qs + r * 528 + 256 + ig * 16) = o;
            o.x = pk2(ok1[0], ok1[1]); o.y = pk2(ok1[2], ok1[3]); o.z = pk2(ok1[4], ok1[5]); o.w = pk2(ok1[6], ok1[7]); *(LAS u32x4*)(Ks + r * 528 + ig * 16) = o;
            o.x = pk2(ok2[0], ok2[1]); o.y = pk2(ok2[2], ok2[3]); o.z = pk2(ok2[4], ok2[5]); o.w = pk2(ok2[6], ok2[7]); *(LAS u32x4*)(Ks + r * 528 + 256 + ig * 16) = o;
        }
        { const int r = tid >> 3, ch = tid & 7; const u32x4 vx = pvx;
            LAS unsigned short* vt = (LAS unsigned short*)(VT + (8 * ch) * 144 + r * 2);
            vt[0 * 72] = (unsigned short)(vx.x & 0xffffu); vt[1 * 72] = (unsigned short)(vx.x >> 16); vt[2 * 72] = (unsigned short)(vx.y & 0xffffu); vt[3 * 72] = (unsigned short)(vx.y >> 16);
            vt[4 * 72] = (unsigned short)(vx.z & 0xffffu); vt[5 * 72] = (unsigned short)(vx.z >> 16); vt[6 * 72] = (unsigned short)(vx.w & 0xffffu); vt[7 * 72] = (unsigned short)(vx.w >> 16); }
        LBAR();
        { const float kd = __expf(lg * (float)(63 - lane));
#pragma unroll
          for (int i = 0; i < 2; ++i) { const int r = lane, ig = w + 8 * i;
            const u32x4 ka_ = *(const LAS u32x4*)(Ks + r * 528 + ig * 16), kb_ = *(const LAS u32x4*)(Ks + r * 528 + 256 + ig * 16);
            LAS unsigned short* kt = (LAS unsigned short*)(KTs + (8 * ig) * 144 + r * 2);
            const unsigned a0 = pk2(bflo(ka_.x) * kd, bfhi(ka_.x) * kd), a1 = pk2(bflo(ka_.y) * kd, bfhi(ka_.y) * kd), a2 = pk2(bflo(ka_.z) * kd, bfhi(ka_.z) * kd), a3 = pk2(bflo(ka_.w) * kd, bfhi(ka_.w) * kd);
            const unsigned b0 = pk2(bflo(kb_.x) * kd, bfhi(kb_.x) * kd), b1 = pk2(bflo(kb_.y) * kd, bfhi(kb_.y) * kd), b2 = pk2(bflo(kb_.z) * kd, bfhi(kb_.z) * kd), b3 = pk2(bflo(kb_.w) * kd, bfhi(kb_.w) * kd);
            kt[0 * 72] = (unsigned short)a0; kt[1 * 72] = (unsigned short)(a0 >> 16); kt[2 * 72] = (unsigned short)a1; kt[3 * 72] = (unsigned short)(a1 >> 16);
            kt[4 * 72] = (unsigned short)a2; kt[5 * 72] = (unsigned short)(a2 >> 16); kt[6 * 72] = (unsigned short)a3; kt[7 * 72] = (unsigned short)(a3 >> 16);
            kt[128 * 72] = (unsigned short)b0; kt[129 * 72] = (unsigned short)(b0 >> 16); kt[130 * 72] = (unsigned short)b1; kt[131 * 72] = (unsigned short)(b1 >> 16);
            kt[132 * 72] = (unsigned short)b2; kt[133 * 72] = (unsigned short)(b2 >> 16); kt[134 * 72] = (unsigned short)b3; kt[135 * 72] = (unsigned short)(b3 >> 16); } }
        if (step + 1 < 32) RET_LOAD(step + 1);
        f32x4 Y2a = (f32x4){0.f, 0.f, 0.f, 0.f}, Y2b = Y2a;
        {
            f32x4 S0 = Y2a, S1 = Y2a;
            bf16x8 qa[2][2], kf0[2][2], kf1[2][2], hf0[2][2], hf1[2][2];
#define RET_B_LOAD(buf, kp) do { _Pragma("unroll") for (int kk = 0; kk < 2; ++kk) { const int ko = (32 * (2 * (kp) + kk) + 8 * fq) * 2; \
                qa[buf][kk] = ldsfrag(Qs + t * 528 + ko); kf0[buf][kk] = ldsfrag(Ks + (32 * wc2 + fr) * 528 + ko); kf1[buf][kk] = ldsfrag(Ks + (32 * wc2 + 16 + fr) * 528 + ko); \
                hf0[buf][kk] = ldsfrag(HTb + (32 * wc2 + fr) * 528 + ko); hf1[buf][kk] = ldsfrag(HTb + (32 * wc2 + 16 + fr) * 528 + ko); } } while (0)
            RET_B_LOAD(0, 0);
#pragma unroll
            for (int kp = 0; kp < 4; ++kp) { const int cb = kp & 1;
                if (kp < 3) { if (cb) RET_B_LOAD(0, kp + 1); else RET_B_LOAD(1, kp + 1); }
                __builtin_amdgcn_sched_barrier(0);
#pragma unroll
                for (int kk = 0; kk < 2; ++kk) { S0 = mfma16(kf0[cb][kk], qa[cb][kk], S0); S1 = mfma16(kf1[cb][kk], qa[cb][kk], S1); Y2a = mfma16(hf0[cb][kk], qa[cb][kk], Y2a); Y2b = mfma16(hf1[cb][kk], qa[cb][kk], Y2b); } }
            float wv[8];
#pragma unroll
            for (int j = 0; j < 8; ++j) { const int s = 32 * wc2 + 16 * (j >> 2) + 4 * fq + (j & 3); const float gv = (j < 4) ? S0[j & 3] : S1[j & 3];
                wv[j] = (s <= t) ? gv * __expf(lg * (float)(t - s)) : 0.f; }
            u32x2 o0, o1; o0.x = pk2(wv[0], wv[1]); o0.y = pk2(wv[2], wv[3]); o1.x = pk2(wv[4], wv[5]); o1.y = pk2(wv[6], wv[7]);
            *(LAS u32x2*)(Ss + t * 144 + (32 * wc2 + 4 * fq) * 2) = o0; *(LAS u32x2*)(Ss + t * 144 + (32 * wc2 + 16 + 4 * fq) * 2) = o1;
        }
        LBAR();
        {
            f32x4 Y1a = (f32x4){0.f, 0.f, 0.f, 0.f}, Y1b = Y1a;
            bf16x8 sa[2], sv0[2], sv1[2];
#pragma unroll
            for (int ks = 0; ks < 2; ++ks) { sa[ks] = ldsfrag(Ss + t * 144 + (32 * ks + 8 * fq) * 2); sv0[ks] = ldsfrag(VT + (32 * wc2 + fr) * 144 + (32 * ks + 8 * fq) * 2); sv1[ks] = ldsfrag(VT + (32 * wc2 + 16 + fr) * 144 + (32 * ks + 8 * fq) * 2); }
            __builtin_amdgcn_sched_barrier(0);
#pragma unroll
            for (int ks = 0; ks < 2; ++ks) { Y1a = mfma16(sv0[ks], sa[ks], Y1a); Y1b = mfma16(sv1[ks], sa[ks], Y1b); }
            const float qd = __expf(lg * (float)(t + 1)); const size_t row = (size_t)(R0 + t); float ss = 0.f;
#pragma unroll
            for (int tl = 0; tl < 2; ++tl) { const f32x4 y1 = tl ? Y1b : Y1a, y2 = tl ? Y2b : Y2a;
                const float v0 = y1[0] + qd * y2[0], v1 = y1[1] + qd * y2[1], v2 = y1[2] + qd * y2[2], v3 = y1[3] + qd * y2[3];
                ss += (v0 * v0 + v1 * v1) + (v2 * v2 + v3 * v3);
                u32x2 o; o.x = pk2(v0, v1); o.y = pk2(v2, v3); *(u32x2*)(Y + row * 4096 + 2048 + 512 * h + e0 + 32 * wc2 + 16 * tl + 4 * fq) = o; }
            ss += __shfl_xor(ss, 16); ss += __shfl_xor(ss, 32);
            if (fq == 0) atomicAdd(SSQ + row * 4 + h, ss);
        }
        {
            const float dec = __expf(lg * 64.f);
#pragma unroll
            for (int i = 0; i < 8; ++i) HT[i] = HT[i] * dec;
            bf16x8 va[2], kt0[8], kt1[8];
            va[0] = ldsfrag(VT + t * 144 + (8 * fq) * 2); va[1] = ldsfrag(VT + t * 144 + (32 + 8 * fq) * 2);
#pragma unroll
            for (int i = 0; i < 8; ++i) kt0[i] = ldsfrag(KTs + (128 * wc2 + 16 * i + fr) * 144 + (8 * fq) * 2);
#pragma unroll
            for (int i = 0; i < 8; ++i) kt1[i] = ldsfrag(KTs + (128 * wc2 + 16 * i + fr) * 144 + (32 + 8 * fq) * 2);
            __builtin_amdgcn_sched_barrier(0);
#pragma unroll
            for (int i = 0; i < 8; ++i) HT[i] = mfma16(kt0[i], va[0], HT[i]);
#pragma unroll
            for (int i = 0; i < 8; ++i) HT[i] = mfma16(kt1[i], va[1], HT[i]);
        }
        LBAR();
#pragma unroll
        for (int i = 0; i < 8; ++i) { u32x2 o; o.x = pk2(HT[i][0], HT[i][1]); o.y = pk2(HT[i][2], HT[i][3]); *(LAS u32x2*)(HTb + t * 528 + (128 * wc2 + 16 * i + 4 * fq) * 2) = o; }
    }
    float* hs = p.out + O_RETP + (size_t)(b * 4 + h) * 256 * 512 + e0 + t;
#pragma unroll
    for (int i = 0; i < 8; ++i)
#pragma unroll
        for (int j = 0; j < 4; ++j) hs[(size_t)(128 * wc2 + 16 * i + 4 * fq + j) * 512] = HT[i][j];
    LBAR();
}

DI void ssd_sample_group(const Params& p, LAS unsigned char* lds, int b, int g, int pass) {
    int tid_ = threadIdx.x; asm volatile("" : "+v"(tid_)); const int tid = tid_, lane = tid & 63, w = tid >> 6;
    const bf16* XB = (const bf16*)(p.ws + WS_XBCC); const bf16* PROJ = (const bf16*)(p.ws + WS_PROJ); const float* DT = (const float*)(p.ws + WS_DT);
    bf16* Y = (bf16*)(p.ws + WS_Y); float* SSQ = (float*)(p.ws + (pass ? WS_DUM : WS_SSQS));
    LAS float* xs = (LAS float*)lds; LAS float* Bv = xs + 2048; LAS float* Cv = Bv + 512; LAS float* cbm = Cv + 512; LAS float* dts = cbm + 16;
    const int Rb = TP + 4 * b;
#pragma unroll
    for (int t = 0; t < 4; ++t) xs[t * 512 + tid] = __uint_as_float((unsigned)XB[(size_t)(Rb + t) * 3072 + 512 * g + tid] << 16);
    { const int t = tid >> 7, n = tid & 127; const bf16* src = XB + (size_t)(Rb + t) * 3072; Bv[tid] = __uint_as_float((unsigned)src[2048 + 128 * g + n] << 16); Cv[tid] = __uint_as_float((unsigned)src[2560 + 128 * g + n] << 16); }
    if (tid < 32) dts[tid] = DT[(size_t)(Rb + (tid >> 3)) * 32 + 8 * g + (tid & 7)];
    LBAR();
#pragma unroll
    for (int i = 0; i < 2; ++i) { const int idx = 2 * w + i, t = idx >> 2, s = idx & 3; float d = Cv[t * 128 + lane] * Bv[s * 128 + lane] + Cv[t * 128 + 64 + lane] * Bv[s * 128 + 64 + lane]; d = wave_sum(d); if (lane == 0) cbm[idx] = d; }
    LBAR();
    const int pp = tid >> 3, ns = tid & 7;
    float sstot = 0.f;
    for (int hb = 0; hb < 8; hb += 2) {
        f32x4 hv[2][4]; float zq[2];
#pragma unroll
        for (int hh = 0; hh < 2; ++hh) zq[hh] = __uint_as_float((unsigned)PROJ[(size_t)(Rb + (ns & 3)) * NPROJ + PZ + 64 * (8 * g + hb + hh) + pp] << 16);
#pragma unroll
        for (int hh = 0; hh < 2; ++hh) { const float* h0 = p.in[I_SSSM] + ((size_t)(b * 32 + 8 * g + hb + hh) * 64 + pp) * 128 + 16 * ns;
#pragma unroll
            for (int q = 0; q < 4; ++q) hv[hh][q] = __builtin_nontemporal_load((const f32x4*)(h0 + 4 * q)); }
#pragma unroll
        for (int hh = 0; hh < 2; ++hh) {
            const int h = 8 * g + hb + hh;
            const float a = -expf(p.in[I_ALOG][h]), Dh = p.in[I_SSMD][h];
            float dt[4], la[4], tl[4], xv[4];
#pragma unroll
            for (int t = 0; t < 4; ++t) dt[t] = dts[t * 8 + hb + hh];
            la[0] = dt[0] * a; la[1] = la[0] + dt[1] * a; la[2] = la[1] + dt[2] * a; la[3] = la[2] + dt[3] * a;
#pragma unroll
            for (int s = 0; s < 4; ++s) { xv[s] = xs[s * 512 + (hb + hh) * 64 + pp]; tl[s] = __expf(la[3] - la[s]) * dt[s] * xv[s]; }
            const float dec = __expf(la[3]);
            float* h1 = p.out + O_SSMS + ((size_t)(b * 32 + h) * 64 + pp) * 128 + 16 * ns;
            float d0 = 0.f, d1 = 0.f, d2 = 0.f, d3 = 0.f;
#pragma unroll
            for (int q = 0; q < 4; ++q) { const f32x4 hq = hv[hh][q]; f32x4 hn;
#pragma unroll
                for (int j = 0; j < 4; ++j) { const int n = 16 * ns + 4 * q + j; const float hx = hq[j];
                    d0 += Cv[n] * hx; d1 += Cv[128 + n] * hx; d2 += Cv[256 + n] * hx; d3 += Cv[384 + n] * hx;
                    hn[j] = hx * dec + Bv[n] * tl[0] + Bv[128 + n] * tl[1] + Bv[256 + n] * tl[2] + Bv[384 + n] * tl[3]; }
                __builtin_nontemporal_store(hn, (f32x4*)(h1 + 4 * q)); }
#pragma unroll
            for (int o = 1; o < 8; o <<= 1) { d0 += __shfl_xor(d0, o); d1 += __shfl_xor(d1, o); d2 += __shfl_xor(d2, o); d3 += __shfl_xor(d3, o); }
            if (ns < 4) { const int t = ns; const float dd = (t == 0) ? d0 : (t == 1) ? d1 : (t == 2) ? d2 : d3; const float lt = (t == 0) ? la[0] : (t == 1) ? la[1] : (t == 2) ? la[2] : la[3];
                float y = __expf(lt) * dd;
#pragma unroll
                for (int s = 0; s < 4; ++s) { if (s <= t) y += cbm[t * 4 + s] * __expf(lt - la[s]) * dt[s] * xv[s]; }
                const size_t row = (size_t)(Rb + t); const float z = zq[hh];
                const float xt = (t == 0) ? xv[0] : (t == 1) ? xv[1] : (t == 2) ? xv[2] : xv[3];
                const float v = (y + Dh * xt) * silu(z);
                Y[row * 4096 + 64 * h + pp] = (bf16)f2bf(v); sstot += v * v; }
        }
    }
    sstot += __shfl_xor(sstot, 8); sstot += __shfl_xor(sstot, 16); sstot += __shfl_xor(sstot, 32);
    if (lane < 4) atomicAdd(SSQ + Rb + lane, sstot);
    LBAR();
}

DI void ret_sample_item(const Params& p, LAS unsigned char* lds, int b, int h, int pass) {
    int tid_ = threadIdx.x; asm volatile("" : "+v"(tid_)); const int tid = tid_, lane = tid & 63, w = tid >> 6;
    const bf16* PROJ = (const bf16*)(p.ws + WS_PROJ); const float* ROPE = (const float*)(p.ws + WS_ROPE);
    bf16* Y = (bf16*)(p.ws + WS_Y); float* SSQ = (float*)(p.ws + (pass ? WS_DUM + (size_t)T * 4 : WS_SSQR));
    LAS float* qs = (LAS float*)lds; LAS float* ks = qs + 1024; LAS float* qk = ks + 1024; LAS float* part = qk + 16;
    const int Rb = TP + 4 * b;
    const float lg = log1pf(-exp2f(-5.f - (float)h)), gm = __expf(lg);
    const int e4 = tid & 127, dg = tid >> 7;
    u32x2 vraw[4];
#pragma unroll
    for (int s = 0; s < 4; ++s) vraw[s] = *(const u32x2*)(PROJ + (size_t)(Rb + s) * NPROJ + PV + 512 * h + 4 * e4);
    { const int t = tid >> 7, i = tid & 127; const bf16* prow = PROJ + (size_t)(Rb + t) * NPROJ;
      const float q1 = __uint_as_float((unsigned)prow[PQ + 256 * h + i] << 16), q2 = __uint_as_float((unsigned)prow[PQ + 256 * h + 128 + i] << 16);
      const float k1 = __uint_as_float((unsigned)prow[PK + 256 * h + i] << 16), k2 = __uint_as_float((unsigned)prow[PK + 256 * h + 128 + i] << 16);
      const unsigned rw = ((const unsigned*)ROPE)[(size_t)(2048 + t) * 128 + i]; const float c = h2lo(rw), s = h2hi(rw);
      qs[t * 256 + i] = q1 * c - q2 * s; qs[t * 256 + 128 + i] = q1 * s + q2 * c; ks[t * 256 + i] = k1 * c - k2 * s; ks[t * 256 + 128 + i] = k1 * s + k2 * c; }
    LBAR();
#pragma unroll
    for (int i = 0; i < 2; ++i) { const int idx = 2 * w + i, t = idx >> 2, s = idx & 3; float d = 0.f;
#pragma unroll
        for (int j = 0; j < 4; ++j) d += qs[t * 256 + lane + 64 * j] * ks[s * 256 + lane + 64 * j];
        d = wave_sum(d); if (lane == 0) qk[idx] = d; }
    f32x4 vv[4];
#pragma unroll
    for (int s = 0; s < 4; ++s) vv[s] = (f32x4){bflo(vraw[s].x), bfhi(vraw[s].x), bflo(vraw[s].y), bfhi(vraw[s].y)};
    const float g1 = gm, g2 = gm * gm, g3 = g2 * gm, g4 = g2 * g2;
    f32x4 kv2[4];
    kv2[0] = vv[0] * g3; kv2[1] = vv[1] * g2; kv2[2] = vv[2] * g1; kv2[3] = vv[3];
    f32x4 a0 = (f32x4){0.f, 0.f, 0.f, 0.f}, a1 = a0, a2 = a0, a3 = a0;
    const size_t sbase = (size_t)(b * 4 + h) * 256 * 512 + 4 * e4;
    const float* h0 = p.in[I_SRET] + sbase; float* h1 = p.out + O_RETS + sbase;
    for (int d0 = 64 * dg; d0 < 64 * dg + 64; d0 += 8) {
        f32x4 hv[8];
#pragma unroll
        for (int j = 0; j < 8; ++j) hv[j] = __builtin_nontemporal_load((const f32x4*)(h0 + (size_t)(d0 + j) * 512));
#pragma unroll
        for (int j = 0; j < 8; ++j) { const int d = d0 + j;
            a0 += qs[d] * hv[j]; a1 += qs[256 + d] * hv[j]; a2 += qs[512 + d] * hv[j]; a3 += qs[768 + d] * hv[j];
            const f32x4 hn = hv[j] * g4 + ks[d] * kv2[0] + ks[256 + d] * kv2[1] + ks[512 + d] * kv2[2] + ks[768 + d] * kv2[3];
            __builtin_nontemporal_store(hn, (f32x4*)(h1 + (size_t)d * 512)); }
    }
    *(LAS f32x4*)(part + (dg * 4 + 0) * 512 + 4 * e4) = a0; *(LAS f32x4*)(part + (dg * 4 + 1) * 512 + 4 * e4) = a1;
    *(LAS f32x4*)(part + (dg * 4 + 2) * 512 + 4 * e4) = a2; *(LAS f32x4*)(part + (dg * 4 + 3) * 512 + 4 * e4) = a3;
    LBAR();
    { const int t = dg; f32x4 st = *(LAS f32x4*)(part + (0 * 4 + t) * 512 + 4 * e4) + *(LAS f32x4*)(part + (1 * 4 + t) * 512 + 4 * e4) + *(LAS f32x4*)(part + (2 * 4 + t) * 512 + 4 * e4) + *(LAS f32x4*)(part + (3 * 4 + t) * 512 + 4 * e4);
      const float qd = (t == 0) ? g1 : (t == 1) ? g2 : (t == 2) ? g3 : g4;
      f32x4 y = st * qd;
#pragma unroll
      for (int s = 0; s < 4; ++s) { if (s <= t) { const int df = t - s; const float gd = (df == 0) ? 1.f : (df == 1) ? g1 : (df == 2) ? g2 : g3; y += (qk[t * 4 + s] * gd) * vv[s]; } }
      const size_t row = (size_t)(Rb + t);
      float ss = (y[0] * y[0] + y[1] * y[1]) + (y[2] * y[2] + y[3] * y[3]); ss = wave_sum(ss);
      if (lane == 0) atomicAdd(SSQ + row * 4 + h, ss);
      u32x2 o; o.x = pk2(y[0], y[1]); o.y = pk2(y[2], y[3]); *(u32x2*)(Y + row * 4096 + 2048 + 512 * h + 4 * e4) = o; }
    LBAR();
}

DI void phase_ynorm(const Params& p, int G) {
    int tid_ = threadIdx.x; asm volatile("" : "+v"(tid_)); const int lane = tid_ & 63, w = tid_ >> 6; const int gw = blockIdx.x * NWV + w, NGW = G * NWV;
    bf16* Y = (bf16*)(p.ws + WS_Y); const bf16* PROJ = (const bf16*)(p.ws + WS_PROJ);
    const float* SSQR = (const float*)(p.ws + WS_SSQR); const float* gr = p.in[I_RETN];
    for (int m = gw; m < T; m += 4 * NGW) {
        u32x4 yv[4][4], gv[4][4]; f32x4 sq[4]; bool ok[4]; int mc[4];
#pragma unroll
        for (int r = 0; r < 4; ++r) { const int mr = m + r * NGW; ok[r] = mr < T; mc[r] = ok[r] ? mr : m; sq[r] = *(const f32x4*)(SSQR + (size_t)mc[r] * 4);
#pragma unroll
            for (int j = 0; j < 4; ++j) { const int c = 8 * (lane + 64 * j); yv[r][j] = __builtin_nontemporal_load((const u32x4*)(Y + (size_t)mc[r] * 4096 + 2048 + c)); gv[r][j] = __builtin_nontemporal_load((const u32x4*)(PROJ + (size_t)mc[r] * NPROJ + PRG + c)); } }
#pragma unroll
        for (int r = 0; r < 4; ++r) { if (ok[r]) {
#pragma unroll
            for (int j = 0; j < 4; ++j) { const int c = 8 * (lane + 64 * j);
                const float rr = __builtin_amdgcn_rsqf(sq[r][j] * (1.f / 512.f) + 1e-6f);
                const u32x4 v = yv[r][j], gt = gv[r][j]; const f32x4 g0 = *(const f32x4*)(gr + c), g1 = *(const f32x4*)(gr + c + 4); u32x4 o;
                o.x = pk2(bflo(v.x) * rr * g0[0] * silu(bflo(gt.x)), bfhi(v.x) * rr * g0[1] * silu(bfhi(gt.x))); o.y = pk2(bflo(v.y) * rr * g0[2] * silu(bflo(gt.y)), bfhi(v.y) * rr * g0[3] * silu(bfhi(gt.y)));
                o.z = pk2(bflo(v.z) * rr * g1[0] * silu(bflo(gt.z)), bfhi(v.z) * rr * g1[1] * silu(bfhi(gt.z))); o.w = pk2(bflo(v.w) * rr * g1[2] * silu(bflo(gt.w)), bfhi(v.w) * rr * g1[3] * silu(bfhi(gt.w)));
                *(u32x4*)(Y + (size_t)mc[r] * 4096 + 2048 + c) = o; } } }
    }
}

#ifndef REP_P4
#define REP_P4 1
#endif
#ifndef REP_SMALL
#define REP_SMALL 1
#endif
#ifndef P0_REP
#define P0_REP 0
#endif
#ifndef NPASS
#define NPASS 1
#endif
#ifndef PROBE_MASK
#define PROBE_MASK 15
#endif
#define GEMM_PHASE(EpiT, Aptr, Bptr, Nn, Kk, LDA, LDB, Eobj) do { pg8::Gemm g_{(const pg8::bf16_t*)(Aptr), (const pg8::bf16_t*)(Bptr), T, (Nn), (Kk), (LDA), (LDB)}; pg8::StaticOrder S_; S_.init(T, (Nn), (Kk), G, (int)blockIdx.x); \
    pg8::gemm_phase<EpiT, pg8::StaticOrder, true, true>(lds, g_, S_, (Eobj)); } while (0)

#define GEMM_SPLIT(EpiT, Aptr, Bptr, Kk, Kc, LDA, LDB, Eobj) do { pg8::Gemm g_{(const pg8::bf16_t*)(Aptr), (const pg8::bf16_t*)(Bptr), T, 1024, (Kk), (LDA), (LDB)}; pg8::SplitOrder S_; S_.init(1024, (Kk), (Kc), G, (int)blockIdx.x); \
    pg8::gemm_phase<EpiT, pg8::SplitOrder, true, true>(lds, g_, S_, (Eobj)); } while (0)

__global__ void __launch_bounds__(NTHR) mega_fwd(Params p) {
    extern __shared__ __attribute__((aligned(16))) unsigned char lds_raw[];
    LAS unsigned char* lds = (LAS unsigned char*)lds_raw;
    cg::grid_group grid = cg::this_grid();
    const int G = gridDim.x; unsigned char* ws = p.ws;
    bf16* XN = (bf16*)(ws + WS_XN); bf16* ACT = (bf16*)(ws + WS_ACT); float* H1 = (float*)(ws + WS_H1); bf16* PROJ = (bf16*)(ws + WS_PROJ);
    bf16* Yb = (bf16*)(ws + WS_Y); float* PART = (float*)(ws + WS_ACT); bf16* MERGED = (bf16*)(ws + WS_XN);

    unsigned* bw = (unsigned*)(ws + WS_BAR);
    if (threadIdx.x < 2) ((volatile LAS unsigned*)(lds + LDS_BYTES - 64))[threadIdx.x] = 0u;
    if (ws == nullptr) grid.sync();
    if (blockIdx.x == 0) {
        for (int i = threadIdx.x; i < 3584; i += NTHR) __hip_atomic_store(bw + i, 0u, __ATOMIC_RELAXED, __HIP_MEMORY_SCOPE_AGENT);
        asm volatile("s_waitcnt vmcnt(0)" ::: "memory"); __syncthreads();
        if (threadIdx.x == 0) { __builtin_amdgcn_fence(__ATOMIC_RELEASE, "agent"); __hip_atomic_store(bw + 3840, 0x600DF1A9u, __ATOMIC_RELAXED, __HIP_MEMORY_SCOPE_AGENT); }
    }
    phase0(p, lds, G, 7);
    phase0(p, lds, G, P0_REP);
    if (blockIdx.x != 0 && threadIdx.x == 0) { unsigned sp = 0; while (__hip_atomic_load(bw + 3840, __ATOMIC_RELAXED, __HIP_MEMORY_SCOPE_AGENT) != 0x600DF1A9u) { __builtin_amdgcn_s_sleep(2); if (++sp > (1u << 22)) break; }
        __builtin_amdgcn_fence(__ATOMIC_ACQUIRE, "agent"); asm volatile("s_waitcnt vmcnt(0)" ::: "memory"); }
    __syncthreads();
    const XcdBarrier bar = xcd_barrier_post(bw, (volatile LAS unsigned*)(lds + LDS_BYTES - 64));
    xcd_barrier(bar);
    { EpiSwiGLU E{ACT}; GEMM_PHASE(EpiSwiGLU, XN, ws + WS_W13A, 5632, 1024, 1024, 1024, E); }
    xcd_barrier(bar);
    float* SL = (float*)(ws + WS_PARTS);
    { EpiRes E{p.in[I_XP], p.in[I_XS], H1, 0.5f, SL}; GEMM_SPLIT(EpiRes, ACT, ws + WS_W2A, FF, 256, FF, FF, E); }
    xcd_barrier(bar);
    phase_rms(H1, p.in[I_NMIX], XN, G, p.in[I_XS], SL, 11);
    xcd_barrier(bar);
    for (int rep = 0; rep < REP_P4; ++rep) { EpiProj E{PROJ, (float*)(ws + WS_DT), p.in[I_DTB]}; GEMM_PHASE(EpiProj, XN, ws + WS_WIN, NPK, 1024, 1024, 1024, E); }
    xcd_barrier(bar);
    phase_conv(p, G);
    xcd_barrier(bar);
    {
        const int bx = blockIdx.x; const int vcu = (G % 8 == 0) ? (bx % 8) * (G / 8) + bx / 8 : bx;
        const bool samples_first = (bx & 1) != 0;
        for (int pass = 0; pass < NPASS; ++pass)
        for (int ph = 0; ph < 2; ++ph) {
            if ((ph == 0) == samples_first) {
                if (pass == 0 || (PROBE_MASK & 4)) for (int i = vcu; i < 512; i += G) ret_sample_item(p, lds, i >> 2, i & 3, pass);
                if (pass == 0 || (PROBE_MASK & 8)) for (int i = vcu; i < 512; i += G) ssd_sample_group(p, lds, i >> 2, i & 3, pass);
            } else {
                if (pass == 0 || (PROBE_MASK & 1)) for (int i = vcu; i < 256; i += G) ret_prompt_item(p, lds, i >> 5, (i >> 3) & 3, i & 7, pass);
                if (pass == 0 || (PROBE_MASK & 2)) for (int i = vcu; i < 256; i += G) ssd_prompt_item(p, lds, i >> 5, i & 31, pass);
            }
        }
    }
    xcd_barrier(bar);
    phase_ynorm(p, G);
    xcd_barrier(bar);
    { EpiGate1 E{PROJ, PART, (float*)(ws + WS_PARTS), (const float*)(ws + WS_SSQS)}; GEMM_SPLIT(EpiGate1, Yb, ws + WS_WBS, 2048, 256, 4096, 2048, E); }
    { EpiGate2 E{PROJ, PART, MERGED, (float*)(ws + WS_PARTS)}; GEMM_SPLIT(EpiGate2, Yb + 2048, ws + WS_WBR, 2048, 256, 4096, 2048, E); }
    xcd_barrier(bar);
    {
        int tid_ = threadIdx.x; asm volatile("" : "+v"(tid_)); const f32x4* ps4 = (const f32x4*)SL; u32x2* mo = (u32x2*)(MERGED + (size_t)TP * 1024);
        for (int e = blockIdx.x * NTHR + tid_; e < 512 * 256; e += G * NTHR) { f32x4 v = ps4[e];
#pragma unroll
            for (int k = 1; k < 16; ++k) v += ps4[(size_t)k * 512 * 256 + e];
            u32x2 o; o.x = pk2(v[0], v[1]); o.y = pk2(v[2], v[3]); mo[e] = o; }
    }
    xcd_barrier(bar);
    { EpiRes E{H1, H1 + (size_t)TP * 1024, H1, 1.0f, SL}; GEMM_SPLIT(EpiRes, MERGED, ws + WS_WO, 1024, 256, 1024, 1024, E); }
    xcd_barrier(bar);
    phase_rms(H1, p.in[I_NF2], XN, G, H1 + (size_t)TP * 1024, SL, 4);
    xcd_barrier(bar);
    { EpiSwiGLU E{ACT}; GEMM_PHASE(EpiSwiGLU, XN, ws + WS_W13B, 5632, 1024, 1024, 1024, E); }
    xcd_barrier(bar);
    { EpiRes E{H1, H1 + (size_t)TP * 1024, p.out + O_Y, 0.5f, SL}; GEMM_SPLIT(EpiRes, ACT, ws + WS_W2B, FF, 256, FF, FF, E); }
    xcd_barrier(bar);
    {
        const float* g = p.in[I_NFIN]; int tid_ = threadIdx.x; asm volatile("" : "+v"(tid_)); const int lane = tid_ & 63, gw = blockIdx.x * NWV + (tid_ >> 6), NGW = G * NWV;
        f32x4 gg[4];
#pragma unroll
        for (int j = 0; j < 4; ++j) gg[j] = *((const f32x4*)g + lane + 64 * j);
        for (int m = gw; m < TP; m += 4 * NGW) { f32x4 v[4][4]; bool ok[4]; int mc[4];
#pragma unroll
            for (int r = 0; r < 4; ++r) { const int mr = m + r * NGW; ok[r] = mr < TP; mc[r] = ok[r] ? mr : m;
#pragma unroll
                for (int j = 0; j < 4; ++j) v[r][j] = __builtin_nontemporal_load((const f32x4*)(p.out + O_Y + (size_t)mc[r] * 1024) + lane + 64 * j); }
#pragma unroll
            for (int r = 0; r < 4; ++r) { float s = 0.f;
#pragma unroll
                for (int j = 0; j < 4; ++j) s += (v[r][j][0] * v[r][j][0] + v[r][j][1] * v[r][j][1]) + (v[r][j][2] * v[r][j][2] + v[r][j][3] * v[r][j][3]);
                const float rstd = __builtin_amdgcn_rsqf(wave_sum(s) * (1.f / 1024.f) + 1e-6f);
                if (ok[r]) {
#pragma unroll
                    for (int j = 0; j < 4; ++j) __builtin_nontemporal_store(v[r][j] * rstd * gg[j], (f32x4*)(p.out + O_Y + (size_t)mc[r] * 1024) + lane + 64 * j); } } }
        for (int r = gw; r < 512; r += NGW) { f32x4 v[4]; float s = 0.f;
#pragma unroll
            for (int j = 0; j < 4; ++j) v[j] = *((const f32x4*)(H1 + (size_t)(TP + r) * 1024) + lane + 64 * j);
            for (int k = 0; k < 11; ++k) {
#pragma unroll
                for (int j = 0; j < 4; ++j) v[j] += *((const f32x4*)(SL + ((size_t)k * 512 + r) * 1024) + lane + 64 * j); }
#pragma unroll
            for (int j = 0; j < 4; ++j) s += (v[j][0] * v[j][0] + v[j][1] * v[j][1]) + (v[j][2] * v[j][2] + v[j][3] * v[j][3]);
            const float rstd = __builtin_amdgcn_rsqf(wave_sum(s) * (1.f / 1024.f) + 1e-6f);
#pragma unroll
            for (int j = 0; j < 4; ++j) *((f32x4*)(p.out + O_Y + (size_t)(TP + r) * 1024) + lane + 64 * j) = v[j] * rstd * gg[j]; }
    }
    __syncthreads();
    if (threadIdx.x == 0) { unsigned* bw2 = (unsigned*)(ws + WS_BAR); const unsigned old = __hip_atomic_fetch_add(bw2 + 3520, 1u, __ATOMIC_RELAXED, __HIP_MEMORY_SCOPE_AGENT);
        if (old == (unsigned)G - 1u) { __hip_atomic_store(bw2 + 3840, 0u, __ATOMIC_RELAXED, __HIP_MEMORY_SCOPE_AGENT); __hip_atomic_store(bw2 + 3520, 0u, __ATOMIC_RELAXED, __HIP_MEMORY_SCOPE_AGENT); } }
}

extern "C" void kernel_launch(void* const* d_in, const int* in_sizes, int n_in, void* d_out, int out_size, void* d_ws, size_t ws_size, hipStream_t stream) {
    static int grid = 0;
    if (grid == 0) {
        if (n_in != 26 || ws_size < WS_END) { fprintf(stderr, "kernel_launch: need 26 inputs and %zu bytes of workspace (got %d, %zu)\n", (size_t)WS_END, n_in, ws_size); grid = -1; return; }
        int dev = 0, cus = 0, per_cu = 0;
        hipGetDevice(&dev); hipDeviceGetAttribute(&cus, hipDeviceAttributeMultiprocessorCount, dev);
        if (hipFuncSetAttribute((const void*)mega_fwd, hipFuncAttributeMaxDynamicSharedMemorySize, LDS_BYTES) != hipSuccess) { fprintf(stderr, "kernel_launch: hipFuncSetAttribute failed\n"); grid = -1; return; }
        if (hipOccupancyMaxActiveBlocksPerMultiprocessor(&per_cu, (const void*)mega_fwd, NTHR, LDS_BYTES) != hipSuccess || per_cu < 1) { fprintf(stderr, "kernel_launch: occupancy query says %d\n", per_cu); grid = -1; return; }
        grid = cus * 1;
    }
    if (grid < 0) return;
    Params p{};
    for (int i = 0; i < 26; ++i) p.in[i] = (const float*)d_in[i];
    p.out = (float*)d_out; p.ws = (unsigned char*)d_ws;
    void* args[] = {&p};
    hipError_t e = hipLaunchCooperativeKernel((const void*)mega_fwd, dim3(grid), dim3(NTHR), args, LDS_BYTES, stream);
    if (e != hipSuccess) fprintf(stderr, "cooperative launch failed: %s (grid %d)\n", hipGetErrorString(e), grid);
}
```

```cpp
#include <hip/hip_runtime.h>
#include <hip/hip_cooperative_groups.h>
#include <cstdio>
#include <cstdint>
namespace cg = cooperative_groups;
namespace pg8 {
#define PG8_LAS __attribute__((address_space(3)))
typedef unsigned short bf16_t;
typedef short bf16x8 __attribute__((ext_vector_type(8)));
typedef float f32x4 __attribute__((ext_vector_type(4)));
typedef unsigned u32x4 __attribute__((ext_vector_type(4)));
constexpr int BM = 256, BK = 64, HALF = 128, HTB = HALF * BK * 2  , STAGE_BYTES = 8 * HTB, NXCD = 8, WGM = 2;

__host__ __device__ __forceinline__ int lds_byte(int r, int c) { const int st = (r >> 4) * 2 + (c >> 5), rr = r & 15, cc = c & 31, ob = rr * 64 + cc * 2; return st * 1024 + (ob ^ (((ob >> 9) & 1) << 5)); }
__host__ __device__ __forceinline__ void stage_rc(int b, int& R, int& C) { const int st = b / 1024, sb = b % 1024, swz = sb ^ (((sb >> 9) & 1) << 5); R = (st >> 1) * 16 + swz / 64; C = (st & 1) * 32 + (swz % 64) / 2; }
__host__ __device__ __forceinline__ int perm32(int rho) { const int n = rho >> 4, i = rho & 15; return 8 * (i >> 2) + 4 * n + (i & 3); }

struct Unit { int pm, pn, kofs, nt, split, ks; };
struct Gemm { const bf16_t* A; const bf16_t* Bt; int M, N, K, lda, ldb; };

struct StaticOrder {
    int nM, nN, nwg, G, c, ntf;
    __host__ __device__ __forceinline__ void init(int M, int N, int K, int G_, int c_) { nM = M / BM; nN = N / BM; nwg = nM * nN; G = G_; c = c_; ntf = K / BK; }
    __host__ __device__ __forceinline__ void map(int wgid, int& pm, int& pn) const {
        { const int q = nwg / NXCD, r = nwg % NXCD, xcd = wgid % NXCD, off = wgid / NXCD; wgid = (xcd < r ? xcd * (q + 1) : r * (q + 1) + (xcd - r) * q) + off; }
        const int nig = WGM * nN, gid = wgid / nig, fm = gid * WGM, gsz = (nM - fm) < WGM ? (nM - fm) : WGM;
        pm = fm + ((wgid % nig) % gsz); pn = (wgid % nig) / gsz;
    }
    __host__ __device__ __forceinline__ bool next(int i, Unit& u) const {
        const long L = (long)i * G + c; const bool ok = L < nwg; int pm, pn; map(ok ? (int)L : 0, pm, pn);
        u.pm = pm; u.pn = pn; u.kofs = 0; u.nt = ntf; u.split = 0; u.ks = 0; return ok;
    }
    __device__ __forceinline__ void a_ready(const Unit&) const {}
    __device__ __forceinline__ void done(const Unit&) const {}
};

struct SplitOrder {
    StaticOrder so; int S, Kc, G, c, nfull;
    __host__ __device__ __forceinline__ void init(int N, int K, int Kc_, int G_, int c_) { so.init(16384, N, K, G_, c_); S = K / Kc_; Kc = Kc_; G = G_; c = c_; nfull = so.nwg; }
    __host__ __device__ __forceinline__ bool next(int i, Unit& u) const {
        const long L = (long)i * G + c; const bool full = L < nfull; int pm, pn; so.map(full ? (int)L : 0, pm, pn);
        const long L2l = L - nfull; const bool sp = !full && L2l < 8 * S; const int L2 = sp ? (int)L2l : 0, per = 4 * S, rem = L2 % per, ks = rem % S;
        u.pm = full ? pm : 64 + L2 / per; u.pn = full ? pn : rem / S; u.ks = full ? 0 : ks; u.kofs = full ? 0 : ks * Kc * 2; u.nt = full ? so.ntf : Kc / BK; u.split = full ? 0 : 1;
        return full || sp;
    }
    __device__ __forceinline__ void a_ready(const Unit&) const {}
    __device__ __forceinline__ void done(const Unit&) const {}
};

typedef __bf16 bf16x2v __attribute__((ext_vector_type(2)));
typedef float f32x2v __attribute__((ext_vector_type(2)));
__device__ __forceinline__ unsigned cvt_pk_bf16(float lo, float hi) { const f32x2v v = {lo, hi}; return __builtin_bit_cast(unsigned, __builtin_convertvector(v, bf16x2v)); }
template <class Epi, class Sched, bool ALIGN_EPI = false, bool SP2 = false>
__device__ __forceinline__ void gemm_phase(PG8_LAS unsigned char* lds, const Gemm g, const Sched& S, const Epi& E) {
    int tid_ = threadIdx.x; asm volatile("" : "+v"(tid_));
    const int tid = tid_, wid = __builtin_amdgcn_readfirstlane(tid >> 6), lane = tid & 63, wr = wid >> 2, wc = wid & 3, fr = lane & 15, fq = lane >> 4;
    unsigned voffA[2], voffB[2];
#pragma unroll
    for (int i = 0; i < 2; ++i) { int R, C; stage_rc(tid * 16 + i * 8192, R, C); const int Rb = Epi::PERM ? ((R & ~31) + perm32(R & 31)) : R;
        voffA[i] = (unsigned)(R * g.lda + C) * 2u; voffB[i] = (unsigned)(Rb * g.ldb + C) * 2u; }
    const size_t kstep = (size_t)(BK * 2);
    const size_t hstepA = (size_t)HALF * g.lda * 2, hstepB = (size_t)HALF * g.ldb * 2;
    const size_t tstepA = 2 * hstepA, tstepB = 2 * hstepB;
    const unsigned ldsw = (unsigned)wid * 1024u;
    const int aoff = lds_byte(wr * 64 + fr, fq * 8), boff = lds_byte(wc * 32 + fr, fq * 8);
#define PG8_SA(b, h) (((b) * 2 + (h)) * HTB)
#define PG8_SB(b, h) ((4 + (b) * 2 + (h)) * HTB)
#define PG8_STAGE(bufoff, gbase, voff) do { _Pragma("unroll") for (int _i = 0; _i < 2; ++_i) \
        __builtin_amdgcn_global_load_lds((const unsigned*)((const char*)(gbase) + (voff)[_i]), (PG8_LAS unsigned*)(lds + (bufoff) + ldsw + _i * 8192), 16, 0, 0); } while (0)
#define PG8_LDA(dst, b, h) do { _Pragma("unroll") for (int m = 0; m < 4; ++m) _Pragma("unroll") for (int k = 0; k < 2; ++k) dst[m][k] = *(const PG8_LAS bf16x8*)(lds + PG8_SA(b, h) + aoff + m * 2048 + k * 1024); } while (0)
#define PG8_LDB(dst, b, h) do { _Pragma("unroll") for (int n = 0; n < 2; ++n) _Pragma("unroll") for (int k = 0; k < 2; ++k) dst[n][k] = *(const PG8_LAS bf16x8*)(lds + PG8_SB(b, h) + boff + n * 2048 + k * 1024); } while (0)
#define PG8_MMA(ai, bj, At, Bt) do { __builtin_amdgcn_s_setprio(1); _Pragma("unroll") for (int m = 0; m < 4; ++m) _Pragma("unroll") for (int n = 0; n < 2; ++n) _Pragma("unroll") for (int k = 0; k < 2; ++k) \
        acc[ai][bj][m][n] = __builtin_amdgcn_mfma_f32_16x16x32_bf16(Bt[n][k], At[m][k], acc[ai][bj][m][n], 0, 0, 0); __builtin_amdgcn_s_setprio(0); } while (0)
#define PG8_WAIT_V(n) asm volatile("s_waitcnt vmcnt(" #n ")" ::: "memory")
#define PG8_WAIT_L(n) asm volatile("s_waitcnt lgkmcnt(" #n ")" ::: "memory")
#define PG8_BAR __builtin_amdgcn_s_barrier()
#define PG8_SCHED __builtin_amdgcn_sched_barrier(0)
    Unit cur, nxt; int ui = 0;
    if (!S.next(0, cur)) return;
    f32x4 acc[2][2][4][2];
#pragma unroll
    for (int a = 0; a < 2; ++a)
#pragma unroll
        for (int b = 0; b < 2; ++b)
#pragma unroll
            for (int m = 0; m < 4; ++m)
#pragma unroll
                for (int n = 0; n < 2; ++n) acc[a][b][m][n] = (f32x4){0.f, 0.f, 0.f, 0.f};
    bf16x8 At[4][2], B0[2][2], B1[2][2];
    const char* cA = (const char*)g.A + (size_t)cur.pm * tstepA + cur.kofs; const char* cB = (const char*)g.Bt + (size_t)cur.pn * tstepB + cur.kofs;
    S.a_ready(cur);
    if constexpr (SP2) {
        PG8_STAGE(PG8_SB(0, 0), cB, voffB); PG8_STAGE(PG8_SB(0, 1), cB + hstepB, voffB); PG8_STAGE(PG8_SA(0, 0), cA, voffA); PG8_STAGE(PG8_SA(0, 1), cA + hstepA, voffA);
        if (wr == 1) PG8_BAR;
        PG8_WAIT_V(2); PG8_BAR;
        PG8_STAGE(PG8_SB(1, 0), cB + kstep, voffB); PG8_STAGE(PG8_SA(1, 0), cA + kstep, voffA); PG8_STAGE(PG8_SB(1, 1), cB + hstepB + kstep, voffB);
        PG8_WAIT_V(6); PG8_BAR;
    } else {
        PG8_STAGE(PG8_SB(0, 0), cB, voffB); PG8_STAGE(PG8_SA(0, 0), cA, voffA); PG8_STAGE(PG8_SB(0, 1), cB + hstepB, voffB); PG8_STAGE(PG8_SA(0, 1), cA + hstepA, voffA);
        if (wr == 1) PG8_BAR;
        PG8_WAIT_V(4); PG8_BAR;
        PG8_STAGE(PG8_SB(1, 0), cB + kstep, voffB); PG8_STAGE(PG8_SA(1, 0), cA + kstep, voffA); PG8_STAGE(PG8_SB(1, 1), cB + hstepB + kstep, voffB);
        PG8_WAIT_V(6); PG8_BAR;
    }
    for (;;) {
        const bool has_next = S.next(ui + 1, nxt);
        const char* nA = has_next ? (const char*)g.A + (size_t)nxt.pm * tstepA + nxt.kofs : cA; const char* nB = has_next ? (const char*)g.Bt + (size_t)nxt.pn * tstepB + nxt.kofs : cB;
        const int nt = cur.nt;
        for (int t = 0; t < nt; t += 2) {
            const bool last = (t == nt - 2);
            const char* a1 = cA + (size_t)(t + 1) * kstep;
            const char* a2 = last ? nA : cA + (size_t)(t + 2) * kstep; const char* b2 = last ? nB : cB + (size_t)(t + 2) * kstep;
            const char* a3 = a2 + kstep; const char* b3 = b2 + kstep;
            if (last && has_next) S.a_ready(nxt);
            if constexpr (SP2) {
            PG8_LDB(B0, 0, 0); PG8_LDB(B1, 0, 1); PG8_SCHED; PG8_LDA(At, 0, 0); PG8_STAGE(PG8_SA(1, 1), a1 + hstepA, voffA);
            PG8_WAIT_V(8); PG8_WAIT_L(0); PG8_BAR; PG8_MMA(0, 0, At, B0); PG8_MMA(0, 1, At, B1); PG8_BAR; PG8_SCHED;
            PG8_LDA(At, 0, 1); PG8_STAGE(PG8_SB(0, 0), b2, voffB); PG8_STAGE(PG8_SB(0, 1), b2 + hstepB, voffB); PG8_STAGE(PG8_SA(0, 0), a2, voffA);
            PG8_WAIT_V(8); PG8_WAIT_L(0); PG8_BAR; PG8_MMA(1, 0, At, B0); PG8_MMA(1, 1, At, B1); PG8_BAR; PG8_SCHED;
            PG8_LDB(B0, 1, 0); PG8_LDB(B1, 1, 1); PG8_SCHED; PG8_LDA(At, 1, 0); PG8_STAGE(PG8_SA(0, 1), a2 + hstepA, voffA);
            PG8_WAIT_V(8); PG8_WAIT_L(0); PG8_BAR; PG8_MMA(0, 0, At, B0); PG8_MMA(0, 1, At, B1); PG8_BAR; PG8_SCHED;
            PG8_LDA(At, 1, 1); PG8_STAGE(PG8_SB(1, 0), b3, voffB); PG8_STAGE(PG8_SB(1, 1), b3 + hstepB, voffB); PG8_STAGE(PG8_SA(1, 0), a3, voffA);
            PG8_WAIT_V(8); PG8_WAIT_L(0); PG8_BAR; PG8_MMA(1, 0, At, B0); PG8_MMA(1, 1, At, B1); PG8_BAR; PG8_SCHED;
            } else {
            PG8_LDB(B0, 0, 0); PG8_SCHED; PG8_LDA(At, 0, 0); PG8_STAGE(PG8_SA(1, 1), a1 + hstepA, voffA);
            PG8_WAIT_L(8); PG8_BAR; PG8_WAIT_L(0); PG8_MMA(0, 0, At, B0); PG8_BAR; PG8_SCHED;
            PG8_LDB(B1, 0, 1); PG8_STAGE(PG8_SB(0, 0), b2, voffB);
            PG8_BAR; PG8_WAIT_L(0); PG8_MMA(0, 1, At, B1); PG8_BAR;
            PG8_LDA(At, 0, 1); PG8_STAGE(PG8_SA(0, 0), a2, voffA);
            PG8_BAR; PG8_WAIT_L(0); PG8_MMA(1, 0, At, B0); PG8_BAR; PG8_SCHED;
            PG8_STAGE(PG8_SB(0, 1), b2 + hstepB, voffB);
            PG8_WAIT_V(6); PG8_BAR; PG8_MMA(1, 1, At, B1); PG8_BAR;
            PG8_LDB(B0, 1, 0); PG8_SCHED; PG8_LDA(At, 1, 0); PG8_STAGE(PG8_SA(0, 1), a2 + hstepA, voffA);
            PG8_WAIT_L(8); PG8_BAR; PG8_WAIT_L(0); PG8_MMA(0, 0, At, B0); PG8_BAR; PG8_SCHED;
            PG8_LDB(B1, 1, 1); PG8_STAGE(PG8_SB(1, 0), b3, voffB);
            PG8_BAR; PG8_WAIT_L(0); PG8_MMA(0, 1, At, B1); PG8_BAR;
            PG8_LDA(At, 1, 1); PG8_STAGE(PG8_SA(1, 0), a3, voffA);
            PG8_BAR; PG8_WAIT_L(0); PG8_MMA(1, 0, At, B0); PG8_BAR; PG8_SCHED;
            PG8_STAGE(PG8_SB(1, 1), b3 + hstepB, voffB);
            PG8_WAIT_V(6); PG8_BAR; PG8_MMA(1, 1, At, B1); PG8_BAR;
            }
        }
        if constexpr (ALIGN_EPI) { if (wr == 0) PG8_BAR; }
        if constexpr (!Epi::AFTER_DRAIN) { E(acc, cur, wr, wc, fr, fq); S.done(cur); }
        if (!has_next) break;
#pragma unroll
        for (int a = 0; a < 2; ++a)
#pragma unroll
            for (int b = 0; b < 2; ++b)
#pragma unroll
                for (int m = 0; m < 4; ++m)
#pragma unroll
                    for (int n = 0; n < 2; ++n) acc[a][b][m][n] = (f32x4){0.f, 0.f, 0.f, 0.f};
        cur = nxt; cA = nA; cB = nB; ++ui;
        if constexpr (ALIGN_EPI) { if (wr == 1) PG8_BAR; }
    }
    PG8_WAIT_V(0);
    if constexpr (!ALIGN_EPI) { if (wr == 0) PG8_BAR; }
    PG8_BAR;
    if constexpr (Epi::AFTER_DRAIN) { E.fused(acc, cur, wr, wc, fr, fq, lds, wid, lane); S.done(cur); }
#undef PG8_SA
#undef PG8_SB
#undef PG8_STAGE
#undef PG8_LDA
#undef PG8_LDB
#undef PG8_MMA
#undef PG8_WAIT_V
#undef PG8_WAIT_L
#undef PG8_BAR
#undef PG8_SCHED
}
}

#define LAS __attribute__((address_space(3)))
typedef unsigned short bf16;
typedef pg8::bf16x8 bf16x8;
typedef pg8::f32x4 f32x4;
typedef pg8::u32x4 u32x4;
typedef unsigned u32x2 __attribute__((ext_vector_type(2)));
constexpr int T = 16896, TP = 16384, DM = 1024, FF = 2816, NPROJ = 13312, NPK = 13568, SEQ = 2048;
constexpr int PZ = 0, PXBC = 2048, PQ = 5120, PK = 6144, PV = 7168, PRG = 9216, PGA = 11264, PGB = 12288;
constexpr int NTHR = 512, NWV = 8;
constexpr int LDS_BYTES = 160 * 1024;

constexpr size_t al256(size_t x) { return (x + 255) & ~(size_t)255; }
constexpr size_t WS_W13A = 0;
constexpr size_t WS_W13B = WS_W13A + al256((size_t)5632 * 1024 * 2);
constexpr size_t WS_W2A  = WS_W13B + al256((size_t)5632 * 1024 * 2);
constexpr size_t WS_W2B  = WS_W2A + al256((size_t)1024 * 2816 * 2);
constexpr size_t WS_WIN  = WS_W2B + al256((size_t)1024 * 2816 * 2);
constexpr size_t WS_WBS  = WS_WIN + al256((size_t)NPK * 1024 * 2);
constexpr size_t WS_WBR  = WS_WBS + al256((size_t)1024 * 2048 * 2);
constexpr size_t WS_WO   = WS_WBR + al256((size_t)1024 * 2048 * 2);
constexpr size_t WS_XN   = WS_WO + al256((size_t)1024 * 1024 * 2);
constexpr size_t WS_ACT  = WS_XN + al256((size_t)T * 1024 * 2);
constexpr size_t WS_H1   = WS_ACT + al256((size_t)T * FF * 2);
constexpr size_t WS_PROJ = WS_H1 + al256((size_t)T * 1024 * 4);
constexpr size_t WS_DT   = WS_PROJ + al256((size_t)T * NPROJ * 2);
constexpr size_t WS_XBCC = WS_DT + al256((size_t)T * 32 * 4);
constexpr size_t WS_Y    = WS_XBCC + al256((size_t)T * 3072 * 2);
constexpr size_t WS_ROPE = WS_Y + al256((size_t)T * 4096 * 2);
constexpr size_t WS_SSQS = WS_ROPE + al256((size_t)2052 * 128 * 2 * 4);
constexpr size_t WS_SSQR = WS_SSQS + al256((size_t)T * 4);
constexpr size_t WS_BAR  = WS_SSQR + al256((size_t)T * 16);
constexpr size_t WS_PARTS = WS_BAR + 16384;
constexpr size_t WS_DUM  = WS_PARTS + (size_t)16 * 512 * 1024 * 4;
constexpr size_t WS_END  = WS_DUM + al256((size_t)T * 20);

constexpr size_t O_Y = 0, O_SSMP = (size_t)T * 1024, O_CONVP = O_SSMP + (size_t)8 * 32 * 64 * 128, O_RETP = O_CONVP + (size_t)8 * 3 * 3072,
                 O_SSMS = O_RETP + (size_t)8 * 4 * 256 * 512, O_CONVS = O_SSMS + (size_t)128 * 32 * 64 * 128, O_RETS = O_CONVS + (size_t)128 * 3 * 3072;

struct Params { const float* in[26]; float* out; unsigned char* ws; };
enum { I_XP = 0, I_XS, I_SSSM, I_SCONV, I_SRET, I_NF1, I_F1W1, I_F1W3, I_F1W2, I_NMIX, I_WIN, I_CONVW, I_CONVB, I_DTB, I_ALOG, I_SSMD, I_SSMN, I_RETN,
       I_WBS, I_WBR, I_WO, I_NF2, I_F2W1, I_F2W3, I_F2W2, I_NFIN };

#define DI __device__ __forceinline__
#define LDS_WAIT() asm volatile("s_waitcnt lgkmcnt(0)" ::: "memory")
#define LBAR() do { asm volatile("s_waitcnt lgkmcnt(0)" ::: "memory"); __builtin_amdgcn_s_barrier(); asm volatile("" ::: "memory"); } while (0)
typedef _Float16 h2_t __attribute__((ext_vector_type(2)));
DI float h2lo(unsigned w) { return (float)__builtin_bit_cast(h2_t, w).x; }
DI float h2hi(unsigned w) { return (float)__builtin_bit_cast(h2_t, w).y; }
DI float bflo(unsigned w) { return __uint_as_float(w << 16); }
DI float bfhi(unsigned w) { return __uint_as_float(w & 0xffff0000u); }
typedef __bf16 bf16x2_t __attribute__((ext_vector_type(2)));
typedef float f32x2_t __attribute__((ext_vector_type(2)));
DI unsigned pk2(float lo, float hi) { const f32x2_t v = {lo, hi}; return __builtin_bit_cast(unsigned, __builtin_convertvector(v, bf16x2_t)); }
DI unsigned f2bf(float f) { return pk2(f, 0.f) & 0xffffu; }
DI float sigm(float x) { return __builtin_amdgcn_rcpf(1.f + __expf(-x)); }
DI float silu(float x) { return x * __builtin_amdgcn_rcpf(1.f + __expf(-x)); }
DI float wave_sum(float v) {
#pragma unroll
    for (int o = 1; o < 64; o <<= 1) v += __shfl_xor(v, o);
    return v;
}
DI f32x4 mfma16(bf16x8 a, bf16x8 b, f32x4 c) { return __builtin_amdgcn_mfma_f32_16x16x32_bf16(a, b, c, 0, 0, 0); }
DI bf16x8 ldsfrag(const LAS unsigned char* p) { return *(const LAS bf16x8*)p; }

#define XB_TMO      128
#define XB_XCNT(j)  (256  + 64 * (j))
#define XB_XSUB(j)  (1280 + 64 * (j))
#define XB_XGEN(j)  (2304 + 64 * (j))
#define XB_TOP      3328
#define XB_TOPGEN   3392
#define XCD_BAR_WORDS 3456
#define XB_SPIN_CAP (1u << 18)

__device__ __forceinline__ unsigned xb_ld(unsigned* p)              { return __hip_atomic_load(p, __ATOMIC_RELAXED, __HIP_MEMORY_SCOPE_AGENT); }
__device__ __forceinline__ unsigned xb_add(unsigned* p, unsigned v) { return __hip_atomic_fetch_add(p, v, __ATOMIC_RELAXED, __HIP_MEMORY_SCOPE_AGENT); }
__device__ __forceinline__ unsigned xb_xcc_id() { return (unsigned)__builtin_amdgcn_s_getreg((3 << 11) | 20) & 0xFu; }
#define XB_SPIN(cond, bar) do { unsigned _sp = 0; while (cond) { __builtin_amdgcn_s_sleep(1); \
    if ((++_sp & 255u) == 0u) { if (xb_ld(&(bar)[XB_TMO])) break; if (_sp > XB_SPIN_CAP) { atomicAdd(&(bar)[XB_TMO], 1u); break; } } } } while (0)

struct XcdBarrier {
    unsigned* bar; unsigned x;
    volatile LAS unsigned* st;
};

__device__ __forceinline__ XcdBarrier xcd_barrier_post(unsigned* bar, volatile LAS unsigned* st) {
    XcdBarrier b; b.bar = bar; b.x = xb_xcc_id(); b.st = st;
    if (threadIdx.x == 0) (void)xb_add(&bar[XB_XCNT(b.x)], 1u);
    return b;
}
__device__ __forceinline__ void xcd_barrier_complete(unsigned* bar, unsigned x, unsigned& nloc, unsigned& nx) {
    const unsigned G = gridDim.x * gridDim.y * gridDim.z;
    unsigned sum, cnt, mine, sp = 0u;
    for (;;) {
        sum = 0u; cnt = 0u; mine = 0u;
#pragma unroll
        for (unsigned j = 0; j < 16; ++j) { const unsigned c = xb_ld(&bar[XB_XCNT(j)]); sum += c; cnt += (c > 0u) ? 1u : 0u; mine = (j == x) ? c : mine; }
        if (sum == G) break;
        __builtin_amdgcn_s_sleep(1);
        if ((++sp & 255u) == 0u) { if (xb_ld(&bar[XB_TMO])) break; if (sp > XB_SPIN_CAP) { atomicAdd(&bar[XB_TMO], 1u); break; } }
    }
    nloc = mine > 0u ? mine : 1u; nx = cnt > 0u ? cnt : 1u;
}

__device__ __forceinline__ void xcd_barrier(const XcdBarrier& b) {
    asm volatile("s_waitcnt vmcnt(0)" ::: "memory");
    __syncthreads();
    if (threadIdx.x == 0) {
        unsigned* bar = b.bar;
        __builtin_amdgcn_s_waitcnt(0);
        unsigned nloc = b.st[0], nx = b.st[1];
        if (nloc == 0u) { xcd_barrier_complete(bar, b.x, nloc, nx); b.st[0] = nloc; b.st[1] = nx; }
        const unsigned old = xb_add(&bar[XB_XSUB(b.x)], 1u);
        const unsigned gen = old / nloc;
        if (old + 1u == (gen + 1u) * nloc) {
            __builtin_amdgcn_fence(__ATOMIC_RELEASE, "agent");
            asm volatile("s_waitcnt vmcnt(0)" ::: "memory");
            const unsigned og = xb_add(&bar[XB_TOP], 1u);
            const unsigned tg = og / nx;
            if (og + 1u == (tg + 1u) * nx) xb_add(&bar[XB_TOPGEN], 1u);
            else XB_SPIN(xb_ld(&bar[XB_TOPGEN]) == tg, bar);
            __builtin_amdgcn_fence(__ATOMIC_ACQUIRE, "agent");
            xb_add(&bar[XB_XGEN(b.x)], 1u);
            asm volatile("s_waitcnt vmcnt(0)" ::: "memory");
        } else {
            XB_SPIN(xb_ld(&bar[XB_XGEN(b.x)]) == gen, bar);
            __builtin_amdgcn_fence(__ATOMIC_ACQUIRE, "agent");
            asm volatile("s_waitcnt vmcnt(0)" ::: "memory");
        }
    }
    __syncthreads();
}

struct EpiSwiGLU {
    static constexpr bool PERM = true, AFTER_DRAIN = false;
    bf16* O;
    DI void operator()(const f32x4 (&acc)[2][2][4][2], const pg8::Unit& u, int wr, int wc, int fr, int fq) const {
        const int row0 = u.pm * 256 + wr * 64 + fr, col0 = u.pn * 128 + wc * 32 + 8 * fq;
#pragma unroll
        for (int ai = 0; ai < 2; ++ai)
#pragma unroll
            for (int m = 0; m < 4; ++m) {
                const f32x4 a0 = acc[ai][0][m][0], a1 = acc[ai][0][m][1], b0 = acc[ai][1][m][0], b1 = acc[ai][1][m][1];
                u32x4 w;
                w.x = pg8::cvt_pk_bf16(silu(a0[0]) * b0[0], silu(a0[1]) * b0[1]); w.y = pg8::cvt_pk_bf16(silu(a0[2]) * b0[2], silu(a0[3]) * b0[3]);
                w.z = pg8::cvt_pk_bf16(silu(a1[0]) * b1[0], silu(a1[1]) * b1[1]); w.w = pg8::cvt_pk_bf16(silu(a1[2]) * b1[2], silu(a1[3]) * b1[3]);
                *(u32x4*)(O + (size_t)(row0 + ai * 128 + m * 16) * FF + col0) = w;
            }
    }
};
struct EpiRes {
    static constexpr bool PERM = false, AFTER_DRAIN = false;
    const float* base; const float* base2; float* out; float alpha; float* SL;
    DI void operator()(const f32x4 (&acc)[2][2][4][2], const pg8::Unit& u, int wr, int wc, int fr, int fq) const {
        const int row0 = u.pm * 256 + wr * 64 + fr, col0 = u.pn * 256 + wc * 32 + 4 * fq;
        const float* bp = (u.pm < 64) ? base : (base2 - (size_t)TP * 1024);
        if (u.split) {
#pragma unroll
            for (int ai = 0; ai < 2; ++ai)
#pragma unroll
                for (int m = 0; m < 4; ++m) { float* op = SL + ((size_t)u.ks * 512 + (size_t)(row0 + ai * 128 + m * 16 - TP)) * 1024 + col0;
#pragma unroll
                    for (int bj = 0; bj < 2; ++bj)
#pragma unroll
                        for (int n = 0; n < 2; ++n) *(f32x4*)(op + bj * 128 + n * 16) = alpha * acc[ai][bj][m][n]; }
            return;
        }
#pragma unroll
        for (int ai = 0; ai < 2; ++ai)
#pragma unroll
            for (int m = 0; m < 4; ++m) {
                const size_t off = (size_t)(row0 + ai * 128 + m * 16) * 1024 + col0;
#pragma unroll
                for (int bj = 0; bj < 2; ++bj)
#pragma unroll
                    for (int n = 0; n < 2; ++n) { const f32x4 b = *(const f32x4*)(bp + off + bj * 128 + n * 16); *(f32x4*)(out + off + bj * 128 + n * 16) = b + alpha * acc[ai][bj][m][n]; }
            }
    }
};
struct EpiProj {
    static constexpr bool PERM = true, AFTER_DRAIN = false;
    bf16* O; float* DT; const float* dtb;
    DI void operator()(const f32x4 (&acc)[2][2][4][2], const pg8::Unit& u, int wr, int wc, int fr, int fq) const {
        const int row0 = u.pm * 256 + wr * 64 + fr;
        if (u.pn < 52) {
            const int col0 = u.pn * 256 + wc * 32 + 8 * fq;
#pragma unroll
            for (int ai = 0; ai < 2; ++ai)
#pragma unroll
                for (int m = 0; m < 4; ++m) { bf16* rowp = O + (size_t)(row0 + ai * 128 + m * 16) * NPROJ + col0;
#pragma unroll
                    for (int bj = 0; bj < 2; ++bj) { const f32x4 v0 = acc[ai][bj][m][0], v1 = acc[ai][bj][m][1]; u32x4 w;
                        w.x = pg8::cvt_pk_bf16(v0[0], v0[1]); w.y = pg8::cvt_pk_bf16(v0[2], v0[3]); w.z = pg8::cvt_pk_bf16(v1[0], v1[1]); w.w = pg8::cvt_pk_bf16(v1[2], v1[3]);
                        *(u32x4*)(rowp + bj * 128) = w; } }
        } else if (wc == 0) {
            const int c0 = 8 * fq;
            const f32x4 bb0 = *(const f32x4*)(dtb + c0), bb1 = *(const f32x4*)(dtb + c0 + 4);
#pragma unroll
            for (int ai = 0; ai < 2; ++ai)
#pragma unroll
                for (int m = 0; m < 4; ++m) { float* rowp = DT + (size_t)(row0 + ai * 128 + m * 16) * 32 + c0;
                    f32x4 v0 = acc[ai][0][m][0] + bb0, v1 = acc[ai][0][m][1] + bb1;
#pragma unroll
                    for (int j = 0; j < 4; ++j) { v0[j] = fmaxf(v0[j], 0.f) + log1pf(expf(-fabsf(v0[j]))); v1[j] = fmaxf(v1[j], 0.f) + log1pf(expf(-fabsf(v1[j]))); }
                    *(f32x4*)rowp = v0; *(f32x4*)(rowp + 4) = v1; }
        }
    }
};
DI void gate_split(const f32x4 (&acc)[2][2][4][2], const pg8::Unit& u, int wr, int wc, int fr, int fq, const bf16* PROJ, int gcol, float* SL, int sbase, const float* SSQ) {
    const int row0 = u.pm * 256 + wr * 64 + fr, col0 = u.pn * 256 + wc * 32 + 8 * fq;
#pragma unroll
    for (int ai = 0; ai < 2; ++ai)
#pragma unroll
        for (int m = 0; m < 4; ++m) { const size_t r = (size_t)(row0 + ai * 128 + m * 16); const float rs = SSQ ? __builtin_amdgcn_rsqf(SSQ[r] * (1.f / 2048.f) + 1e-5f) : 1.f;
#pragma unroll
            for (int bj = 0; bj < 2; ++bj) { const u32x4 gw = *(const u32x4*)(PROJ + r * NPROJ + gcol + col0 + bj * 128);
                const f32x4 v0 = acc[ai][bj][m][0] * rs, v1 = acc[ai][bj][m][1] * rs; float* pp = SL + ((size_t)(sbase + u.ks) * 512 + (r - TP)) * 1024 + col0 + bj * 128; f32x4 o0, o1;
                o0[0] = sigm(bflo(gw.x)) * v0[0]; o0[1] = sigm(bfhi(gw.x)) * v0[1]; o0[2] = sigm(bflo(gw.y)) * v0[2]; o0[3] = sigm(bfhi(gw.y)) * v0[3];
                o1[0] = sigm(bflo(gw.z)) * v1[0]; o1[1] = sigm(bfhi(gw.z)) * v1[1]; o1[2] = sigm(bflo(gw.w)) * v1[2]; o1[3] = sigm(bfhi(gw.w)) * v1[3];
                *(f32x4*)pp = o0; *(f32x4*)(pp + 4) = o1; } }
}
struct EpiGate1 {
    static constexpr bool PERM = true, AFTER_DRAIN = false;
    const bf16* PROJ; float* PART; float* PARTS; const float* SSQ;
    DI void operator()(const f32x4 (&acc)[2][2][4][2], const pg8::Unit& u, int wr, int wc, int fr, int fq) const {
        if (u.split) { gate_split(acc, u, wr, wc, fr, fq, PROJ, PGA, PARTS, 0, SSQ); return; }
        const int row0 = u.pm * 256 + wr * 64 + fr, col0 = u.pn * 256 + wc * 32 + 8 * fq;
#pragma unroll
        for (int ai = 0; ai < 2; ++ai)
#pragma unroll
            for (int m = 0; m < 4; ++m) { const size_t r = (size_t)(row0 + ai * 128 + m * 16); const float rs = __builtin_amdgcn_rsqf(SSQ[r] * (1.f / 2048.f) + 1e-5f);
#pragma unroll
                for (int bj = 0; bj < 2; ++bj) { const u32x4 gw = *(const u32x4*)(PROJ + r * NPROJ + PGA + col0 + bj * 128);
                    const f32x4 v0 = acc[ai][bj][m][0] * rs, v1 = acc[ai][bj][m][1] * rs; f32x4 o0, o1;
                    o0[0] = sigm(bflo(gw.x)) * v0[0]; o0[1] = sigm(bfhi(gw.x)) * v0[1]; o0[2] = sigm(bflo(gw.y)) * v0[2]; o0[3] = sigm(bfhi(gw.y)) * v0[3];
                    o1[0] = sigm(bflo(gw.z)) * v1[0]; o1[1] = sigm(bfhi(gw.z)) * v1[1]; o1[2] = sigm(bflo(gw.w)) * v1[2]; o1[3] = sigm(bfhi(gw.w)) * v1[3];
                    float* pp = PART + r * 1024 + col0 + bj * 128; *(f32x4*)pp = o0; *(f32x4*)(pp + 4) = o1; } }
    }
};
struct EpiGate2 {
    static constexpr bool PERM = true, AFTER_DRAIN = false;
    const bf16* PROJ; const float* PART; bf16* O; float* PARTS;
    DI void operator()(const f32x4 (&acc)[2][2][4][2], const pg8::Unit& u, int wr, int wc, int fr, int fq) const {
        if (u.split) { gate_split(acc, u, wr, wc, fr, fq, PROJ, PGB, PARTS, 8, nullptr); return; }
        const int row0 = u.pm * 256 + wr * 64 + fr, col0 = u.pn * 256 + wc * 32 + 8 * fq;
#pragma unroll
        for (int ai = 0; ai < 2; ++ai)
#pragma unroll
            for (int m = 0; m < 4; ++m) { const size_t r = (size_t)(row0 + ai * 128 + m * 16);
#pragma unroll
                for (int bj = 0; bj < 2; ++bj) { const u32x4 gw = *(const u32x4*)(PROJ + r * NPROJ + PGB + col0 + bj * 128);
                    const float* pp = PART + r * 1024 + col0 + bj * 128; const f32x4 p0 = *(const f32x4*)pp, p1 = *(const f32x4*)(pp + 4);
                    const f32x4 v0 = acc[ai][bj][m][0], v1 = acc[ai][bj][m][1]; u32x4 w;
                    w.x = pg8::cvt_pk_bf16(p0[0] + sigm(bflo(gw.x)) * v0[0], p0[1] + sigm(bfhi(gw.x)) * v0[1]);
                    w.y = pg8::cvt_pk_bf16(p0[2] + sigm(bflo(gw.y)) * v0[2], p0[3] + sigm(bfhi(gw.y)) * v0[3]);
                    w.z = pg8::cvt_pk_bf16(p1[0] + sigm(bflo(gw.z)) * v1[0], p1[1] + sigm(bfhi(gw.z)) * v1[1]);
                    w.w = pg8::cvt_pk_bf16(p1[2] + sigm(bflo(gw.w)) * v1[2], p1[3] + sigm(bfhi(gw.w)) * v1[3]);
                    *(u32x4*)(O + r * 1024 + col0 + bj * 128) = w; } }
    }
};

DI void pack_item64(const float* W, int ldw, int col0a, int col0b, float scale, bool zeroa, bool zerob, bf16* WT, int K, int nrow0, int k0, LAS float* scr, int lane, const float* gk) {
    const int half = (lane >> 3) & 1, c4 = (lane & 7) * 4, kr = lane >> 4;
    const int colsrc = (half ? col0b : col0a) + c4; const bool zr = half ? zerob : zeroa;
    f32x4 v[16];
    const float* wp = W + (size_t)(k0 + kr) * ldw + colsrc;
#pragma unroll
    for (int i = 0; i < 16; ++i) v[i] = zr ? (f32x4){0.f, 0.f, 0.f, 0.f} : __builtin_nontemporal_load((const f32x4*)(wp + (size_t)(4 * i) * ldw));
#pragma unroll
    for (int i = 0; i < 16; ++i) { LAS float* d = scr + (4 * i + kr) * 65 + 32 * half + c4; d[0] = v[i][0] * scale; d[1] = v[i][1] * scale; d[2] = v[i][2] * scale; d[3] = v[i][3] * scale; }
    LDS_WAIT();
    const int c = lane & 7;
    f32x4 g0 = (f32x4){1.f, 1.f, 1.f, 1.f}, g1 = g0;
    if (gk) { g0 = *(const f32x4*)(gk + k0 + 8 * c); g1 = *(const f32x4*)(gk + k0 + 8 * c + 4); }
#pragma unroll
    for (int j = 0; j < 8; ++j) { const int n = (lane >> 3) + 8 * j; const LAS float* s = scr + (8 * c) * 65 + n;
        u32x4 o; o.x = pk2(s[0 * 65] * g0[0], s[1 * 65] * g0[1]); o.y = pk2(s[2 * 65] * g0[2], s[3 * 65] * g0[3]); o.z = pk2(s[4 * 65] * g1[0], s[5 * 65] * g1[1]); o.w = pk2(s[6 * 65] * g1[2], s[7 * 65] * g1[3]);
        *(u32x4*)(WT + (size_t)(nrow0 + n) * K + k0 + 8 * c) = o; }
    LDS_WAIT();
}
template <int NR> DI void rms_rows_bf16(const float* const (&xr)[NR], const bool (&ok)[NR], const float* g, bf16* const (&orow)[NR], int lane, float eps) {
    f32x4 v[NR][4];
#pragma unroll
    for (int r = 0; r < NR; ++r)
#pragma unroll
        for (int j = 0; j < 4; ++j) v[r][j] = __builtin_nontemporal_load((const f32x4*)xr[r] + lane + 64 * j);
    f32x4 gg[4];
#pragma unroll
    for (int j = 0; j < 4; ++j) gg[j] = *((const f32x4*)g + lane + 64 * j);
#pragma unroll
    for (int r = 0; r < NR; ++r) { float s = 0.f;
#pragma unroll
        for (int j = 0; j < 4; ++j) s += (v[r][j][0] * v[r][j][0] + v[r][j][1] * v[r][j][1]) + (v[r][j][2] * v[r][j][2] + v[r][j][3] * v[r][j][3]);
        const float rstd = __builtin_amdgcn_rsqf(wave_sum(s) * (1.f / 1024.f) + eps);
        if (ok[r]) {
#pragma unroll
            for (int j = 0; j < 4; ++j) { u32x2 o; o.x = pk2(v[r][j][0] * rstd * gg[j][0], v[r][j][1] * rstd * gg[j][1]); o.y = pk2(v[r][j][2] * rstd * gg[j][2], v[r][j][3] * rstd * gg[j][3]); *((u32x2*)orow[r] + lane + 64 * j) = o; } } }
}

DI void phase_rms(float* X, const float* g, bf16* O, int G, const float* base_s, const float* SL, int ns) {
    int tid_ = threadIdx.x; asm volatile("" : "+v"(tid_)); const int lane = tid_ & 63, gw = blockIdx.x * NWV + (tid_ >> 6), NGW = G * NWV;
    for (int m = gw; m < TP; m += 4 * NGW) { const float* xr[4]; bf16* orow[4]; bool ok[4];
#pragma unroll
        for (int r = 0; r < 4; ++r) { const int mr = m + r * NGW; ok[r] = mr < TP; const int mc = ok[r] ? mr : m; xr[r] = X + (size_t)mc * 1024; orow[r] = O + (size_t)mc * 1024; }
        rms_rows_bf16<4>(xr, ok, g, orow, lane, 1e-6f); }
    for (int r = gw; r < 512; r += NGW) {
        f32x4 v[4]; float s = 0.f;
#pragma unroll
        for (int j = 0; j < 4; ++j) v[j] = *((const f32x4*)(base_s + (size_t)r * 1024) + lane + 64 * j);
        for (int k = 0; k < ns; ++k) {
#pragma unroll
            for (int j = 0; j < 4; ++j) v[j] += *((const f32x4*)(SL + ((size_t)k * 512 + r) * 1024) + lane + 64 * j); }
        float* xr = X + (size_t)(TP + r) * 1024;
#pragma unroll
        for (int j = 0; j < 4; ++j) { *((f32x4*)xr + lane + 64 * j) = v[j]; s += (v[j][0] * v[j][0] + v[j][1] * v[j][1]) + (v[j][2] * v[j][2] + v[j][3] * v[j][3]); }
        const float rstd = 1.f / sqrtf(wave_sum(s) * (1.f / 1024.f) + 1e-6f);
#pragma unroll
        for (int j = 0; j < 4; ++j) { const f32x4 gg = *((const f32x4*)g + lane + 64 * j); u32x2 o; o.x = pk2(v[j][0] * rstd * gg[0], v[j][1] * rstd * gg[1]); o.y = pk2(v[j][2] * rstd * gg[2], v[j][3] * rstd * gg[3]);
            *((u32x2*)(O + (size_t)(TP + r) * 1024) + lane + 64 * j) = o; }
    }
}

DI void phase0(const Params& p, LAS unsigned char* lds, int G, int pmask) {
    unsigned char* ws = p.ws;
    int tid_ = threadIdx.x; asm volatile("" : "+v"(tid_)); const int tid = tid_, lane = tid & 63, w = tid >> 6;
    const int gw = blockIdx.x * NWV + w, NGW = G * NWV;
    LAS float* scr = (LAS float*)(lds + w * 16640);
    if (pmask & 1) for (int it = gw; it < 8896; it += NGW) {
        const float* src; int ldw, cola, colb, K, nb, kb; float scale = 1.f; bool za = false, zb = false; bf16* WT; const float* gk = nullptr;
        if (it < 2816) { const int mat = it / 1408, r = it % 1408; kb = r / 88; nb = r % 88; const int pn = nb >> 2, wi = nb & 3;
            src = p.in[mat ? (wi < 2 ? I_F2W1 : I_F2W3) : (wi < 2 ? I_F1W1 : I_F1W3)]; ldw = FF; cola = 128 * pn + 64 * (wi & 1); colb = cola + 32; K = 1024; WT = (bf16*)(ws + (mat ? WS_W13B : WS_W13A)); }
        else if (it < 4224) { int r = it - 2816; const int mat = r / 704; r %= 704; kb = r / 16; nb = r % 16; src = p.in[mat ? I_F2W2 : I_F1W2]; ldw = 1024; cola = 64 * nb; colb = cola + 32; K = FF; WT = (bf16*)(ws + (mat ? WS_W2B : WS_W2A)); }
        else if (it < 7616) { const int r = it - 4224; kb = r / 212; nb = r % 212; const int pca = 64 * nb, pcb = pca + 32; za = pca >= 13344; zb = pcb >= 13344;
            cola = pca < 5120 ? pca : (pca < 13312 ? pca + 32 : 5120); colb = pcb < 5120 ? pcb : (pcb < 13312 ? pcb + 32 : 5120); if (za) cola = 0; if (zb) colb = 0;
            scale = (pca >= PK && pca < PV) ? 0.0625f : 1.f; src = p.in[I_WIN]; ldw = 13344; K = 1024; WT = (bf16*)(ws + WS_WIN); }
        else if (it < 8640) { int r = it - 7616; const int mat = r / 512; r %= 512; kb = r / 16; nb = r % 16; src = p.in[mat ? I_WBR : I_WBS]; gk = mat ? nullptr : p.in[I_SSMN]; ldw = 1024; cola = 64 * nb; colb = cola + 32; K = 2048; WT = (bf16*)(ws + (mat ? WS_WBR : WS_WBS)); }
        else { const int r = it - 8640; kb = r / 16; nb = r % 16; src = p.in[I_WO]; ldw = 1024; cola = 64 * nb; colb = cola + 32; K = 1024; WT = (bf16*)(ws + WS_WO); }
        pack_item64(src, ldw, cola, colb, scale, za, zb, WT, K, 64 * nb, 64 * kb, scr, lane, gk);
    }
    if (pmask & 2) for (int m = gw; m < T; m += 4 * NGW) { const float* xr[4]; bf16* orow[4]; bool ok[4];
#pragma unroll
        for (int r = 0; r < 4; ++r) { const int mr = m + r * NGW; ok[r] = mr < T; const int mc = ok[r] ? mr : m;
            xr[r] = (mc < TP) ? p.in[I_XP] + (size_t)mc * 1024 : p.in[I_XS] + (size_t)(mc - TP) * 1024; orow[r] = (bf16*)(ws + WS_XN) + (size_t)mc * 1024; }
        rms_rows_bf16<4>(xr, ok, p.in[I_NF1], orow, lane, 1e-6f); }
    const int gt = blockIdx.x * NTHR + tid, NGT = G * NTHR;
    float* rope = (float*)(ws + WS_ROPE);
    if (pmask & 4) for (int e = gt; e < 2052 * 128; e += NGT) { const int pi = e >> 7, i = e & 127; const double pos = (double)(pi < 2048 ? pi : 16384 + (pi - 2048));
        const double inv = exp(-(double)i * (9.210340371976184 / 128.0)); const double rev = pos * inv * 0.15915494309189535; const double fr = rev - rint(rev);
        const h2_t cs = {(_Float16)__builtin_amdgcn_cosf((float)fr), (_Float16)__builtin_amdgcn_sinf((float)fr)}; ((unsigned*)rope)[e] = __builtin_bit_cast(unsigned, cs); }
    float* ssq = (float*)(ws + WS_SSQS);
    for (int e = gt; e < T; e += NGT) ssq[e] = 0.f;
    float* ssr = (float*)(ws + WS_SSQR);
    for (int e = gt; e < 4 * T; e += NGT) ssr[e] = 0.f;
}

DI void unpack8(const u32x4 a, float (&o)[8]) { o[0] = bflo(a.x); o[1] = bfhi(a.x); o[2] = bflo(a.y); o[3] = bfhi(a.y); o[4] = bflo(a.z); o[5] = bfhi(a.z); o[6] = bflo(a.w); o[7] = bfhi(a.w); }
DI void phase_conv(const Params& p, int G) {
    const bf16* PROJ = (const bf16*)(p.ws + WS_PROJ); bf16* XB = (bf16*)(p.ws + WS_XBCC);
    const float* cw = p.in[I_CONVW]; const float* cb = p.in[I_CONVB];
    int tid_ = threadIdx.x; asm volatile("" : "+v"(tid_));
    const int gt = blockIdx.x * NTHR + tid_, NGT = G * NTHR;
    for (int u = gt; u < 1024 * 384; u += NGT) {
        const int seg = u / 384, cgp = u % 384, c0 = 8 * cgp, row0 = 16 * seg, tseq0 = row0 & (SEQ - 1);
        u32x4 raw[19];
        const bf16* src = PROJ + (size_t)row0 * NPROJ + PXBC + c0;
#pragma unroll
        for (int i = 0; i < 19; ++i) { if (i >= 3 || tseq0 != 0) raw[i] = __builtin_nontemporal_load((const u32x4*)(src + (ptrdiff_t)(i - 3) * NPROJ)); else raw[i] = (u32x4){0u, 0u, 0u, 0u}; }
        float wk[4][8], bb[8];
#pragma unroll
        for (int k = 0; k < 4; ++k) { const f32x4 a = *(const f32x4*)(cw + k * 3072 + c0), b = *(const f32x4*)(cw + k * 3072 + c0 + 4);
#pragma unroll
            for (int j = 0; j < 4; ++j) { wk[k][j] = a[j]; wk[k][4 + j] = b[j]; } }
        { const f32x4 a = *(const f32x4*)(cb + c0), b = *(const f32x4*)(cb + c0 + 4);
#pragma unroll
          for (int j = 0; j < 4; ++j) { bb[j] = a[j]; bb[4 + j] = b[j]; } }
        float r0[8], r1[8], r2[8];
        unpack8(raw[0], r0); unpack8(raw[1], r1); unpack8(raw[2], r2);
#pragma unroll
        for (int i = 0; i < 16; ++i) {
            float cur[8], o[8]; unpack8(raw[i + 3], cur);
#pragma unroll
            for (int j = 0; j < 8; ++j) { o[j] = silu(bb[j] + wk[0][j] * r0[j] + wk[1][j] * r1[j] + wk[2][j] * r2[j] + wk[3][j] * cur[j]); r0[j] = r1[j]; r1[j] = r2[j]; r2[j] = cur[j]; }
            u32x4 w; w.x = pk2(o[0], o[1]); w.y = pk2(o[2], o[3]); w.z = pk2(o[4], o[5]); w.w = pk2(o[6], o[7]);
            *(u32x4*)(XB + (size_t)(row0 + i) * 3072 + c0) = w;
            if (i >= 13 && tseq0 == SEQ - 16) { float* dst = p.out + O_CONVP + ((size_t)(row0 >> 11) * 3 + (i - 13)) * 3072 + c0;
                *(f32x4*)dst = (f32x4){cur[0], cur[1], cur[2], cur[3]}; *(f32x4*)(dst + 4) = (f32x4){cur[4], cur[5], cur[6], cur[7]}; }
        }
    }
    for (int u = gt; u < 128 * 384; u += NGT) {
        const int seg = u / 384, cgp = u % 384, c0 = 8 * cgp, row0 = TP + 4 * seg;
        u32x4 raw[4];
#pragma unroll
        for (int i = 0; i < 4; ++i) raw[i] = *(const u32x4*)(PROJ + (size_t)(row0 + i) * NPROJ + PXBC + c0);
        float wk[4][8], bb[8], r0[8], r1[8], r2[8];
#pragma unroll
        for (int k = 0; k < 4; ++k) { const f32x4 a = *(const f32x4*)(cw + k * 3072 + c0), b = *(const f32x4*)(cw + k * 3072 + c0 + 4);
#pragma unroll
            for (int j = 0; j < 4; ++j) { wk[k][j] = a[j]; wk[k][4 + j] = b[j]; } }
        { const f32x4 a = *(const f32x4*)(cb + c0), b = *(const f32x4*)(cb + c0 + 4);
#pragma unroll
          for (int j = 0; j < 4; ++j) { bb[j] = a[j]; bb[4 + j] = b[j]; } }
        const float* st = p.in[I_SCONV] + (size_t)seg * 3 * 3072 + c0;
#pragma unroll
        for (int j = 0; j < 8; ++j) { r0[j] = st[j]; r1[j] = st[3072 + j]; r2[j] = st[2 * 3072 + j]; }
#pragma unroll
        for (int i = 0; i < 4; ++i) {
            float cur[8], o[8]; unpack8(raw[i], cur);
#pragma unroll
            for (int j = 0; j < 8; ++j) { o[j] = silu(bb[j] + wk[0][j] * r0[j] + wk[1][j] * r1[j] + wk[2][j] * r2[j] + wk[3][j] * cur[j]); r0[j] = r1[j]; r1[j] = r2[j]; r2[j] = cur[j]; }
            u32x4 w; w.x = pk2(o[0], o[1]); w.y = pk2(o[2], o[3]); w.z = pk2(o[4], o[5]); w.w = pk2(o[6], o[7]);
            *(u32x4*)(XB + (size_t)(row0 + i) * 3072 + c0) = w;
            if (i >= 1) { float* dst = p.out + O_CONVS + ((size_t)seg * 3 + (i - 1)) * 3072 + c0;
                *(f32x4*)dst = (f32x4){cur[0], cur[1], cur[2], cur[3]}; *(f32x4*)(dst + 4) = (f32x4){cur[4], cur[5], cur[6], cur[7]}; }
        }
    }
}

DI void ssd_prompt_item(const Params& p, LAS unsigned char* lds, int b, int h, int pass) {
    int tid_ = threadIdx.x; asm volatile("" : "+v"(tid_)); const int tid = tid_, lane = tid & 63, w = tid >> 6, fr = lane & 15, fq = lane >> 4, tr = w >> 1, wc2 = w & 1, g = h >> 3;
    const bf16* XB = (const bf16*)(p.ws + WS_XBCC); const bf16* PROJ = (const bf16*)(p.ws + WS_PROJ); const float* DT = (const float*)(p.ws + WS_DT);
    bf16* Y = (bf16*)(p.ws + WS_Y); float* SSQ = (float*)(p.ws + (pass ? WS_DUM : WS_SSQS));
    LAS unsigned char* Cs = lds; LAS unsigned char* Bs = lds + 17408; LAS unsigned char* BTs = lds + 34816; LAS unsigned char* XT = lds + 53248;
    LAS unsigned char* Ws = lds + 62464; LAS unsigned char* Hb = lds + 71680; LAS float* fla = (LAS float*)(lds + 89088); LAS float* fdt = fla + 64;
    const float a = -expf(p.in[I_ALOG][h]), Dh = p.in[I_SSMD][h];
    for (int i = tid; i < 17408 / 4; i += NTHR) ((LAS unsigned*)Hb)[i] = 0u;
    f32x4 Hacc[4];
#pragma unroll
    for (int i = 0; i < 4; ++i) Hacc[i] = (f32x4){0.f, 0.f, 0.f, 0.f};
    u32x4 pvb[2], pvc[2], pvx, pvz; float pdt;
    const unsigned so_b0 = (unsigned)(((tid >> 4) * 3072 + 2048 + 128 * g + 8 * (tid & 15)) * 2), so_b1 = so_b0 + 32u * 3072u * 2u, so_x = (unsigned)(((tid >> 3) * 3072 + 64 * h + 8 * (tid & 7)) * 2), so_dt = (unsigned)((lane * 32 + h) * 4);
    LAS unsigned char* Xs = lds + 89600;
    LAS unsigned char* Zs = lds + 98816;
    const unsigned so_z = (unsigned)(((tid >> 3) * NPROJ + PZ + 64 * h + 8 * (tid & 7)) * 2);
#define SSD_LOAD(stp) do { const char* xb_ = (const char*)XB + (size_t)(b * SEQ + (stp) * 64) * 3072 * 2; const char* dt_ = (const char*)DT + (size_t)(b * SEQ + (stp) * 64) * 32 * 4; \
        pdt = *(const float*)(dt_ + so_dt); pvb[0] = *(const u32x4*)(xb_ + so_b0); pvc[0] = *(const u32x4*)(xb_ + so_b0 + 1024); pvb[1] = *(const u32x4*)(xb_ + so_b1); pvc[1] = *(const u32x4*)(xb_ + so_b1 + 1024); \
        pvx = *(const u32x4*)(xb_ + so_x); pvz = *(const u32x4*)((const char*)PROJ + (size_t)(b * SEQ + (stp) * 64) * NPROJ * 2 + so_z); } while (0)
    SSD_LOAD(0);
    for (int step = 0; step < 32; ++step) {
        const int R0 = b * SEQ + step * 64;
        const float dtv = pdt;
        float la = dtv * a;
#pragma unroll
        for (int o = 1; o < 64; o <<= 1) { const float t = __shfl_up(la, o); if (lane >= o) la += t; }
        const float la_end = __shfl(la, 63);
        const float tail = __expf(la_end - la) * dtv;
        if (w == 0) { fla[lane] = la; fdt[lane] = dtv; }
#pragma unroll
        for (int i = 0; i < 2; ++i) { const int r = (tid >> 4) + 32 * i, ch = tid & 15;
            *(LAS u32x4*)(Cs + r * 272 + ch * 16) = pvc[i]; *(LAS u32x4*)(Bs + r * 272 + ch * 16) = pvb[i]; }
        { const int r = tid >> 3, ch = tid & 7; *(LAS u32x4*)(Xs + r * 144 + ch * 16) = pvx; *(LAS u32x4*)(Zs + r * 144 + ch * 16) = pvz; }
        LBAR();
#pragma unroll
        for (int i = 0; i < 2; ++i) { const int r = lane, ch = w + 8 * i;
            const u32x4 vb = *(const LAS u32x4*)(Bs + r * 272 + ch * 16); const float tl = tail;
            LAS unsigned short* bt = (LAS unsigned short*)(BTs + (8 * ch) * 144 + r * 2);
            const unsigned w0 = pk2(bflo(vb.x) * tl, bfhi(vb.x) * tl), w1 = pk2(bflo(vb.y) * tl, bfhi(vb.y) * tl), w2 = pk2(bflo(vb.z) * tl, bfhi(vb.z) * tl), w3 = pk2(bflo(vb.w) * tl, bfhi(vb.w) * tl);
            bt[0 * 72] = (unsigned short)w0; bt[1 * 72] = (unsigned short)(w0 >> 16); bt[2 * 72] = (unsigned short)w1; bt[3 * 72] = (unsigned short)(w1 >> 16);
            bt[4 * 72] = (unsigned short)w2; bt[5 * 72] = (unsigned short)(w2 >> 16); bt[6 * 72] = (unsigned short)w3; bt[7 * 72] = (unsigned short)(w3 >> 16); }
        { const int r = lane, ch = w; const u32x4 vx = *(const LAS u32x4*)(Xs + r * 144 + ch * 16);
            LAS unsigned short* xt = (LAS unsigned short*)(XT + (8 * ch) * 144 + r * 2);
            xt[0 * 72] = (unsigned short)(vx.x & 0xffffu); xt[1 * 72] = (unsigned short)(vx.x >> 16); xt[2 * 72] = (unsigned short)(vx.y & 0xffffu); xt[3 * 72] = (unsigned short)(vx.y >> 16);
            xt[4 * 72] = (unsigned short)(vx.z & 0xffffu); xt[5 * 72] = (unsigned short)(vx.z >> 16); xt[6 * 72] = (unsigned short)(vx.w & 0xffffu); xt[7 * 72] = (unsigned short)(vx.w >> 16); }
        if (step + 1 < 32) SSD_LOAD(step + 1);
        const int t = 16 * tr + fr; const float lat = fla[t];
        {
            f32x4 G0 = (f32x4){0.f, 0.f, 0.f, 0.f}, G1 = G0;
            bf16x8 fa[4], fb0[4], fb1[4];
#pragma unroll
            for (int ks = 0; ks < 4; ++ks) { fa[ks] = ldsfrag(Cs + t * 272 + (32 * ks + 8 * fq) * 2); fb0[ks] = ldsfrag(Bs + (32 * wc2 + fr) * 272 + (32 * ks + 8 * fq) * 2); fb1[ks] = ldsfrag(Bs + (32 * wc2 + 16 + fr) * 272 + (32 * ks + 8 * fq) * 2); }
            __builtin_amdgcn_sched_barrier(0);
#pragma unroll
            for (int ks = 0; ks < 4; ++ks) { G0 = mfma16(fb0[ks], fa[ks], G0); G1 = mfma16(fb1[ks], fa[ks], G1); }
            float wv[8];
#pragma unroll
            for (int j = 0; j < 8; ++j) { const int s = 32 * wc2 + 16 * (j >> 2) + 4 * fq + (j & 3); const float gv = (j < 4) ? G0[j & 3] : G1[j & 3];
                wv[j] = (s <= t) ? gv * __expf(lat - fla[s]) * fdt[s] : 0.f; }
            u32x2 o0, o1; o0.x = pk2(wv[0], wv[1]); o0.y = pk2(wv[2], wv[3]); o1.x = pk2(wv[4], wv[5]); o1.y = pk2(wv[6], wv[7]);
            *(LAS u32x2*)(Ws + t * 144 + (32 * wc2 + 4 * fq) * 2) = o0; *(LAS u32x2*)(Ws + t * 144 + (32 * wc2 + 16 + 4 * fq) * 2) = o1;
        }
        LBAR();
        {
            f32x4 Y1a = (f32x4){0.f, 0.f, 0.f, 0.f}, Y1b = Y1a, Y2a = Y1a, Y2b = Y1a;
            {
            bf16x8 wa[2], wx0[2], wx1[2], ca[4], hb0[4], hb1[4];
#pragma unroll
            for (int ks = 0; ks < 2; ++ks) { wa[ks] = ldsfrag(Ws + t * 144 + (32 * ks + 8 * fq) * 2); wx0[ks] = ldsfrag(XT + (32 * wc2 + fr) * 144 + (32 * ks + 8 * fq) * 2); wx1[ks] = ldsfrag(XT + (32 * wc2 + 16 + fr) * 144 + (32 * ks + 8 * fq) * 2); }
#pragma unroll
            for (int ks = 0; ks < 4; ++ks) { ca[ks] = ldsfrag(Cs + t * 272 + (32 * ks + 8 * fq) * 2); hb0[ks] = ldsfrag(Hb + (32 * wc2 + fr) * 272 + (32 * ks + 8 * fq) * 2); hb1[ks] = ldsfrag(Hb + (32 * wc2 + 16 + fr) * 272 + (32 * ks + 8 * fq) * 2); }
            __builtin_amdgcn_sched_barrier(0);
#pragma unroll
            for (int ks = 0; ks < 2; ++ks) { Y1a = mfma16(wx0[ks], wa[ks], Y1a); Y1b = mfma16(wx1[ks], wa[ks], Y1b); }
#pragma unroll
            for (int ks = 0; ks < 4; ++ks) { Y2a = mfma16(hb0[ks], ca[ks], Y2a); Y2b = mfma16(hb1[ks], ca[ks], Y2b); }
            }
            const float el = __expf(lat); const size_t row = (size_t)(R0 + t); float ss = 0.f;
#pragma unroll
            for (int tl = 0; tl < 2; ++tl) { const int pc = 64 * h + 32 * wc2 + 16 * tl + 4 * fq; const f32x4 y1 = tl ? Y1b : Y1a, y2 = tl ? Y2b : Y2a;
                const int pl = (32 * wc2 + 16 * tl + 4 * fq) * 2; const u32x2 xv = *(const LAS u32x2*)(Xs + t * 144 + pl), zv = *(const LAS u32x2*)(Zs + t * 144 + pl);
                const float v0 = (y1[0] + el * y2[0] + Dh * bflo(xv.x)) * silu(bflo(zv.x)), v1 = (y1[1] + el * y2[1] + Dh * bfhi(xv.x)) * silu(bfhi(zv.x));
                const float v2 = (y1[2] + el * y2[2] + Dh * bflo(xv.y)) * silu(bflo(zv.y)), v3 = (y1[3] + el * y2[3] + Dh * bfhi(xv.y)) * silu(bfhi(zv.y));
                ss += (v0 * v0 + v1 * v1) + (v2 * v2 + v3 * v3);
                u32x2 o; o.x = pk2(v0, v1); o.y = pk2(v2, v3); *(u32x2*)(Y + row * 4096 + pc) = o; }
            ss += __shfl_xor(ss, 16); ss += __shfl_xor(ss, 32);
            if (fq == 0) atomicAdd(SSQ + row, ss);
        }
        {
            const float dec = __expf(la_end);
#pragma unroll
            for (int i = 0; i < 4; ++i) Hacc[i] = Hacc[i] * dec;
            bf16x8 xa[2], bt[2][4];
#pragma unroll
            for (int ks = 0; ks < 2; ++ks) { xa[ks] = ldsfrag(XT + t * 144 + (32 * ks + 8 * fq) * 2);
#pragma unroll
                for (int i = 0; i < 4; ++i) bt[ks][i] = ldsfrag(BTs + (64 * wc2 + 16 * i + fr) * 144 + (32 * ks + 8 * fq) * 2); }
            __builtin_amdgcn_sched_barrier(0);
#pragma unroll
            for (int ks = 0; ks < 2; ++ks)
#pragma unroll
                for (int i = 0; i < 4; ++i) Hacc[i] = mfma16(bt[ks][i], xa[ks], Hacc[i]);
        }
        LBAR();
#pragma unroll
        for (int i = 0; i < 4; ++i) { u32x2 o; o.x = pk2(Hacc[i][0], Hacc[i][1]); o.y = pk2(Hacc[i][2], Hacc[i][3]); *(LAS u32x2*)(Hb + t * 272 + (64 * wc2 + 16 * i + 4 * fq) * 2) = o; }
    }
    float* hs = p.out + O_SSMP + ((size_t)(b * 32 + h) * 64 + 16 * tr + fr) * 128 + 64 * wc2 + 4 * fq;
#pragma unroll
    for (int i = 0; i < 4; ++i) *(f32x4*)(hs + 16 * i) = Hacc[i];
    LBAR();
}

DI void ret_prompt_item(const Params& p, LAS unsigned char* lds, int b, int h, int vs, int pass) {
    int tid_ = threadIdx.x; asm volatile("" : "+v"(tid_)); const int tid = tid_, lane = tid & 63, w = tid >> 6, fr = lane & 15, fq = lane >> 4, tr = w >> 1, wc2 = w & 1, e0 = 64 * vs;
    const bf16* PROJ = (const bf16*)(p.ws + WS_PROJ); const float* ROPE = (const float*)(p.ws + WS_ROPE);
    bf16* Y = (bf16*)(p.ws + WS_Y); float* SSQ = (float*)(p.ws + (pass ? WS_DUM + (size_t)T * 4 : WS_SSQR));
    LAS unsigned char* Qs = lds; LAS unsigned char* Ks = lds + 33792; LAS unsigned char* KTs = lds + 67584; LAS unsigned char* VT = lds + 104448;
    LAS unsigned char* Ss = lds + 113664; LAS unsigned char* HTb = lds + 122880;
    const float lg = log1pf(-exp2f(-5.f - (float)h));
    for (int i = tid; i < 33792 / 4; i += NTHR) ((LAS unsigned*)HTb)[i] = 0u;
    f32x4 HT[8];
#pragma unroll
    for (int i = 0; i < 8; ++i) HT[i] = (f32x4){0.f, 0.f, 0.f, 0.f};
    const int t = 16 * tr + fr;
    u32x4 rq1[2], rq2[2], rk1[2], rk2[2], pvx, pr0[2], pr1[2];
    const unsigned ro_q0 = (unsigned)(((tid >> 4) * NPROJ + PQ + 256 * h + 8 * (tid & 15)) * 2), ro_q1 = ro_q0 + 32u * (unsigned)NPROJ * 2u, ro_v = (unsigned)(((tid >> 3) * NPROJ + PV + 512 * h + e0 + 8 * (tid & 7)) * 2);
    const unsigned ro_r0 = (unsigned)(((tid >> 4) * 128 + 8 * (tid & 15)) * 4), ro_r1 = ro_r0 + 32u * 128u * 4u;
#define RET_LOAD(stp) do { const char* pj_ = (const char*)PROJ + (size_t)(b * SEQ + (stp) * 64) * NPROJ * 2; \
        rq1[0] = *(const u32x4*)(pj_ + ro_q0); rq2[0] = *(const u32x4*)(pj_ + ro_q0 + 256); rk1[0] = *(const u32x4*)(pj_ + ro_q0 + 2048); rk2[0] = *(const u32x4*)(pj_ + ro_q0 + 2304); \
        rq1[1] = *(const u32x4*)(pj_ + ro_q1); rq2[1] = *(const u32x4*)(pj_ + ro_q1 + 256); rk1[1] = *(const u32x4*)(pj_ + ro_q1 + 2048); rk2[1] = *(const u32x4*)(pj_ + ro_q1 + 2304); \
        { const char* rp_ = (const char*)ROPE + (size_t)((stp) * 64) * 128 * 4; pr0[0] = *(const u32x4*)(rp_ + ro_r0); pr1[0] = *(const u32x4*)(rp_ + ro_r0 + 16); pr0[1] = *(const u32x4*)(rp_ + ro_r1); pr1[1] = *(const u32x4*)(rp_ + ro_r1 + 16); } \
        pvx = *(const u32x4*)(pj_ + ro_v); } while (0)
    RET_LOAD(0);
    for (int step = 0; step < 32; ++step) {
        const int R0 = b * SEQ + step * 64;
#pragma unroll
        for (int i = 0; i < 2; ++i) { const int r = (tid >> 4) + 32 * i, ig = tid & 15;
            const u32x4 q1 = rq1[i], q2 = rq2[i], k1 = rk1[i], k2 = rk2[i];
            const u32x4 ra = pr0[i], rb = pr1[i];
            float qa[8], qb[8], ka[8], kb[8], cc[8], sn[8];
            qa[0] = bflo(q1.x); qa[1] = bfhi(q1.x); qa[2] = bflo(q1.y); qa[3] = bfhi(q1.y); qa[4] = bflo(q1.z); qa[5] = bfhi(q1.z); qa[6] = bflo(q1.w); qa[7] = bfhi(q1.w);
            qb[0] = bflo(q2.x); qb[1] = bfhi(q2.x); qb[2] = bflo(q2.y); qb[3] = bfhi(q2.y); qb[4] = bflo(q2.z); qb[5] = bfhi(q2.z); qb[6] = bflo(q2.w); qb[7] = bfhi(q2.w);
            ka[0] = bflo(k1.x); ka[1] = bfhi(k1.x); ka[2] = bflo(k1.y); ka[3] = bfhi(k1.y); ka[4] = bflo(k1.z); ka[5] = bfhi(k1.z); ka[6] = bflo(k1.w); ka[7] = bfhi(k1.w);
            kb[0] = bflo(k2.x); kb[1] = bfhi(k2.x); kb[2] = bflo(k2.y); kb[3] = bfhi(k2.y); kb[4] = bflo(k2.z); kb[5] = bfhi(k2.z); kb[6] = bflo(k2.w); kb[7] = bfhi(k2.w);
            cc[0] = h2lo(ra.x); sn[0] = h2hi(ra.x); cc[1] = h2lo(ra.y); sn[1] = h2hi(ra.y); cc[2] = h2lo(ra.z); sn[2] = h2hi(ra.z); cc[3] = h2lo(ra.w); sn[3] = h2hi(ra.w);
            cc[4] = h2lo(rb.x); sn[4] = h2hi(rb.x); cc[5] = h2lo(rb.y); sn[5] = h2hi(rb.y); cc[6] = h2lo(rb.z); sn[6] = h2hi(rb.z); cc[7] = h2lo(rb.w); sn[7] = h2hi(rb.w);
            float oq1[8], oq2[8], ok1[8], ok2[8];
#pragma unroll
            for (int j = 0; j < 8; ++j) { oq1[j] = qa[j] * cc[j] - qb[j] * sn[j]; oq2[j] = qa[j] * sn[j] + qb[j] * cc[j]; ok1[j] = ka[j] * cc[j] - kb[j] * sn[j]; ok2[j] = ka[j] * sn[j] + kb[j] * cc[j]; }
            u32x4 o;
            o.x = pk2(oq1[0], oq1[1]); o.y = pk2(oq1[2], oq1[3]); o.z = pk2(oq1[4], oq1[5]); o.w = pk2(oq1[6], oq1[7]); *(LAS u32x4*)(Qs + r * 528 + ig * 16) = o;
            o.x = pk2(oq2[0], oq2[1]); o.y = pk2(oq2[2], oq2[3]); o.z = pk2(oq2[4], oq2[5]); o.w = pk2(oq2[6], oq2[7]); *(LAS u32x4*)(Qs + r * 528 + 256 + ig * 16) = o;
            o.x = pk2(ok1[0], ok1[1]); o.y = pk2(ok1[2], ok1[3]); o.z = pk2(ok1[4], ok1[5]); o.w = pk2(ok1[6], ok1[7]); *(LAS u32x4*)(Ks + r * 528 + ig * 16) = o;
            o.x = pk2(ok2[0], ok2[1]); o.y = pk2(ok2[2], ok2[3]); o.z = pk2(ok2[4], ok2[5]); o.w = pk2(ok2[6], ok2[7]); *(LAS u32x4*)(Ks + r * 528 + 256 + ig * 16) = o;
        }
        { const int r = tid >> 3, ch = tid & 7; const u32x4 vx = pvx;
            LAS unsigned short* vt = (LAS unsigned short*)(VT + (8 * ch) * 144 + r * 2);
            vt[0 * 72] = (unsigned short)(vx.x & 0xffffu); vt[1 * 72] = (unsigned short)(vx.x >> 16); vt[2 * 72] = (unsigned short)(vx.y & 0xffffu); vt[3 * 72] = (unsigned short)(vx.y >> 16);
            vt[4 * 72] = (unsigned short)(vx.z & 0xffffu); vt[5 * 72] = (unsigned short)(vx.z >> 16); vt[6 * 72] = (unsigned short)(vx.w & 0xffffu); vt[7 * 72] = (unsigned short)(vx.w >> 16); }
        LBAR();
        { const float kd = __expf(lg * (float)(63 - lane));
#pragma unroll
          for (int i = 0; i < 2; ++i) { const int r = lane, ig = w + 8 * i;
            const u32x4 ka_ = *(const LAS u32x4*)(Ks + r * 528 + ig * 16), kb_ = *(const LAS u32x4*)(Ks + r * 528 + 256 + ig * 16);
            LAS unsigned short* kt = (LAS unsigned short*)(KTs + (8 * ig) * 144 + r * 2);
            const unsigned a0 = pk2(bflo(ka_.x) * kd, bfhi(ka_.x) * kd), a1 = pk2(bflo(ka_.y) * kd, bfhi(ka_.y) * kd), a2 = pk2(bflo(ka_.z) * kd, bfhi(ka_.z) * kd), a3 = pk2(bflo(ka_.w) * kd, bfhi(ka_.w) * kd);
            const unsigned b0 = pk2(bflo(kb_.x) * kd, bfhi(kb_.x) * kd), b1 = pk2(bflo(kb_.y) * kd, bfhi(kb_.y) * kd), b2 = pk2(bflo(kb_.z) * kd, bfhi(kb_.z) * kd), b3 = pk2(bflo(kb_.w) * kd, bfhi(kb_.w) * kd);
            kt[0 * 72] = (unsigned short)a0; kt[1 * 72] = (unsigned short)(a0 >> 16); kt[2 * 72] = (unsigned short)a1; kt[3 * 72] = (unsigned short)(a1 >> 16);
            kt[4 * 72] = (unsigned short)a2; kt[5 * 72] = (unsigned short)(a2 >> 16); kt[6 * 72] = (unsigned short)a3; kt[7 * 72] = (unsigned short)(a3 >> 16);
            kt[128 * 72] = (unsigned short)b0; kt[129 * 72] = (unsigned short)(b0 >> 16); kt[130 * 72] = (unsigned short)b1; kt[131 * 72] = (unsigned short)(b1 >> 16);
            kt[132 * 72] = (unsigned short)b2; kt[133 * 72] = (unsigned short)(b2 >> 16); kt[134 * 72] = (unsigned short)b3; kt[135 * 72] = (unsigned short)(b3 >> 16); } }
        if (step + 1 < 32) RET_LOAD(step + 1);
        f32x4 Y2a = (f32x4){0.f, 0.f, 0.f, 0.f}, Y2b = Y2a;
        {
            f32x4 S0 = Y2a, S1 = Y2a;
            bf16x8 qa[2][2], kf0[2][2], kf1[2][2], hf0[2][2], hf1[2][2];
#define RET_B_LOAD(buf, kp) do { _Pragma("unroll") for (int kk = 0; kk < 2; ++kk) { const int ko = (32 * (2 * (kp) + kk) + 8 * fq) * 2; \
                qa[buf][kk] = ldsfrag(Qs + t * 528 + ko); kf0[buf][kk] = ldsfrag(Ks + (32 * wc2 + fr) * 528 + ko); kf1[buf][kk] = ldsfrag(Ks + (32 * wc2 + 16 + fr) * 528 + ko); \
                hf0[buf][kk] = ldsfrag(HTb + (32 * wc2 + fr) * 528 + ko); hf1[buf][kk] = ldsfrag(HTb + (32 * wc2 + 16 + fr) * 528 + ko); } } while (0)
            RET_B_LOAD(0, 0);
#pragma unroll
            for (int kp = 0; kp < 4; ++kp) { const int cb = kp & 1;
                if (kp < 3) { if (cb) RET_B_LOAD(0, kp + 1); else RET_B_LOAD(1, kp + 1); }
                __builtin_amdgcn_sched_barrier(0);
#pragma unroll
                for (int kk = 0; kk < 2; ++kk) { S0 = mfma16(kf0[cb][kk], qa[cb][kk], S0); S1 = mfma16(kf1[cb][kk], qa[cb][kk], S1); Y2a = mfma16(hf0[cb][kk], qa[cb][kk], Y2a); Y2b = mfma16(hf1[cb][kk], qa[cb][kk], Y2b); } }
            float wv[8];
#pragma unroll
            for (int j = 0; j < 8; ++j) { const int s = 32 * wc2 + 16 * (j >> 2) + 4 * fq + (j & 3); const float gv = (j < 4) ? S0[j & 3] : S1[j & 3];
                wv[j] = (s <= t) ? gv * __expf(lg * (float)(t - s)) : 0.f; }
            u32x2 o0, o1; o0.x = pk2(wv[0], wv[1]); o0.y = pk2(wv[2], wv[3]); o1.x = pk2(wv[4], wv[5]); o1.y = pk2(wv[6], wv[7]);
            *(LAS u32x2*)(Ss + t * 144 + (32 * wc2 + 4 * fq) * 2) = o0; *(LAS u32x2*)(Ss + t * 144 + (32 * wc2 + 16 + 4 * fq) * 2) = o1;
        }
        LBAR();
        {
            f32x4 Y1a = (f32x4){0.f, 0.f, 0.f, 0.f}, Y1b = Y1a;
            bf16x8 sa[2], sv0[2], sv1[2];
#pragma unroll
            for (int ks = 0; ks < 2; ++ks) { sa[ks] = ldsfrag(Ss + t * 144 + (32 * ks + 8 * fq) * 2); sv0[ks] = ldsfrag(VT + (32 * wc2 + fr) * 144 + (32 * ks + 8 * fq) * 2); sv1[ks] = ldsfrag(VT + (32 * wc2 + 16 + fr) * 144 + (32 * ks + 8 * fq) * 2); }
            __builtin_amdgcn_sched_barrier(0);
#pragma unroll
            for (int ks = 0; ks < 2; ++ks) { Y1a = mfma16(sv0[ks], sa[ks], Y1a); Y1b = mfma16(sv1[ks], sa[ks], Y1b); }
            const float qd = __expf(lg * (float)(t + 1)); const size_t row = (size_t)(R0 + t); float ss = 0.f;
#pragma unroll
            for (int tl = 0; tl < 2; ++tl) { const f32x4 y1 = tl ? Y1b : Y1a, y2 = tl ? Y2b : Y2a;
                const float v0 = y1[0] + qd * y2[0], v1 = y1[1] + qd * y2[1], v2 = y1[2] + qd * y2[2], v3 = y1[3] + qd * y2[3];
                ss += (v0 * v0 + v1 * v1) + (v2 * v2 + v3 * v3);
                u32x2 o; o.x = pk2(v0, v1); o.y = pk2(v2, v3); *(u32x2*)(Y + row * 4096 + 2048 + 512 * h + e0 + 32 * wc2 + 16 * tl + 4 * fq) = o; }
            ss += __shfl_xor(ss, 16); ss += __shfl_xor(ss, 32);
            if (fq == 0) atomicAdd(SSQ + row * 4 + h, ss);
        }
        {
            const float dec = __expf(lg * 64.f);
#pragma unroll
            for (int i = 0; i < 8; ++i) HT[i] = HT[i] * dec;
            bf16x8 va[2], kt0[8], kt1[8];
            va[0] = ldsfrag(VT + t * 144 + (8 * fq) * 2); va[1] = ldsfrag(VT + t * 144 + (32 + 8 * fq) * 2);
#pragma unroll
            for (int i = 0; i < 8; ++i) kt0[i] = ldsfrag(KTs + (128 * wc2 + 16 * i + fr) * 144 + (8 * fq) * 2);
#pragma unroll
            for (int i = 0; i < 8; ++i) kt1[i] = ldsfrag(KTs + (128 * wc2 + 16 * i + fr) * 144 + (32 + 8 * fq) * 2);
            __builtin_amdgcn_sched_barrier(0);
#pragma unroll
            for (int i = 0; i < 8; ++i) HT[i] = mfma16(kt0[i], va[0], HT[i]);
#pragma unroll
            for (int i = 0; i < 8; ++i) HT[i] = mfma16(kt1[i], va[1], HT[i]);
        }
        LBAR();
#pragma unroll
        for (int i = 0; i < 8; ++i) { u32x2 o; o.x = pk2(HT[i][0], HT[i][1]); o.y = pk2(HT[i][2], HT[i][3]); *(LAS u32x2*)(HTb + t * 528 + (128 * wc2 + 16 * i + 4 * fq) * 2) = o; }
    }
    float* hs = p.out + O_RETP + (size_t)(b * 4 + h) * 256 * 512 + e0 + t;
#pragma unroll
    for (int i = 0; i < 8; ++i)
#pragma unroll
        for (int j = 0; j < 4; ++j) hs[(size_t)(128 * wc2 + 16 * i + 4 * fq + j) * 512] = HT[i][j];
    LBAR();
}

DI void ssd_sample_group(const Params& p, LAS unsigned char* lds, int b, int g, int pass) {
    int tid_ = threadIdx.x; asm volatile("" : "+v"(tid_)); const int tid = tid_, lane = tid & 63, w = tid >> 6;
    const bf16* XB = (const bf16*)(p.ws + WS_XBCC); const bf16* PROJ = (const bf16*)(p.ws + WS_PROJ); const float* DT = (const float*)(p.ws + WS_DT);
    bf16* Y = (bf16*)(p.ws + WS_Y); float* SSQ = (float*)(p.ws + (pass ? WS_DUM : WS_SSQS));
    LAS float* xs = (LAS float*)lds; LAS float* Bv = xs + 2048; LAS float* Cv = Bv + 512; LAS float* cbm = Cv + 512; LAS float* dts = cbm + 16;
    const int Rb = TP + 4 * b;
#pragma unroll
    for (int t = 0; t < 4; ++t) xs[t * 512 + tid] = __uint_as_float((unsigned)XB[(size_t)(Rb + t) * 3072 + 512 * g + tid] << 16);
    { const int t = tid >> 7, n = tid & 127; const bf16* src = XB + (size_t)(Rb + t) * 3072; Bv[tid] = __uint_as_float((unsigned)src[2048 + 128 * g + n] << 16); Cv[tid] = __uint_as_float((unsigned)src[2560 + 128 * g + n] << 16); }
    if (tid < 32) dts[tid] = DT[(size_t)(Rb + (tid >> 3)) * 32 + 8 * g + (tid & 7)];
    LBAR();
#pragma unroll
    for (int i = 0; i < 2; ++i) { const int idx = 2 * w + i, t = idx >> 2, s = idx & 3; float d = Cv[t * 128 + lane] * Bv[s * 128 + lane] + Cv[t * 128 + 64 + lane] * Bv[s * 128 + 64 + lane]; d = wave_sum(d); if (lane == 0) cbm[idx] = d; }
    LBAR();
    const int pp = tid >> 3, ns = tid & 7;
    float sstot = 0.f;
    for (int hb = 0; hb < 8; hb += 2) {
        f32x4 hv[2][4]; float zq[2];
#pragma unroll
        for (int hh = 0; hh < 2; ++hh) zq[hh] = __uint_as_float((unsigned)PROJ[(size_t)(Rb + (ns & 3)) * NPROJ + PZ + 64 * (8 * g + hb + hh) + pp] << 16);
#pragma unroll
        for (int hh = 0; hh < 2; ++hh) { const float* h0 = p.in[I_SSSM] + ((size_t)(b * 32 + 8 * g + hb + hh) * 64 + pp) * 128 + 16 * ns;
#pragma unroll
            for (int q = 0; q < 4; ++q) hv[hh][q] = __builtin_nontemporal_load((const f32x4*)(h0 + 4 * q)); }
#pragma unroll
        for (int hh = 0; hh < 2; ++hh) {
            const int h = 8 * g + hb + hh;
            const float a = -expf(p.in[I_ALOG][h]), Dh = p.in[I_SSMD][h];
            float dt[4], la[4], tl[4], xv[4];
#pragma unroll
            for (int t = 0; t < 4; ++t) dt[t] = dts[t * 8 + hb + hh];
            la[0] = dt[0] * a; la[1] = la[0] + dt[1] * a; la[2] = la[1] + dt[2] * a; la[3] = la[2] + dt[3] * a;
#pragma unroll
            for (int s = 0; s < 4; ++s) { xv[s] = xs[s * 512 + (hb + hh) * 64 + pp]; tl[s] = __expf(la[3] - la[s]) * dt[s] * xv[s]; }
            const float dec = __expf(la[3]);
            float* h1 = p.out + O_SSMS + ((size_t)(b * 32 + h) * 64 + pp) * 128 + 16 * ns;
            float d0 = 0.f, d1 = 0.f, d2 = 0.f, d3 = 0.f;
#pragma unroll
            for (int q = 0; q < 4; ++q) { const f32x4 hq = hv[hh][q]; f32x4 hn;
#pragma unroll
                for (int j = 0; j < 4; ++j) { const int n = 16 * ns + 4 * q + j; const float hx = hq[j];
                    d0 += Cv[n] * hx; d1 += Cv[128 + n] * hx; d2 += Cv[256 + n] * hx; d3 += Cv[384 + n] * hx;
                    hn[j] = hx * dec + Bv[n] * tl[0] + Bv[128 + n] * tl[1] + Bv[256 + n] * tl[2] + Bv[384 + n] * tl[3]; }
                __builtin_nontemporal_store(hn, (f32x4*)(h1 + 4 * q)); }
#pragma unroll
            for (int o = 1; o < 8; o <<= 1) { d0 += __shfl_xor(d0, o); d1 += __shfl_xor(d1, o); d2 += __shfl_xor(d2, o); d3 += __shfl_xor(d3, o); }
            if (ns < 4) { const int t = ns; const float dd = (t == 0) ? d0 : (t == 1) ? d1 : (t == 2) ? d2 : d3; const float lt = (t == 0) ? la[0] : (t == 1) ? la[1] : (t == 2) ? la[2] : la[3];
                float y = __expf(lt) * dd;
#pragma unroll
                for (int s = 0; s < 4; ++s) { if (s <= t) y += cbm[t * 4 + s] * __expf(lt - la[s]) * dt[s] * xv[s]; }
                const size_t row = (size_t)(Rb + t); const float z = zq[hh];
                const float xt = (t == 0) ? xv[0] : (t == 1) ? xv[1] : (t == 2) ? xv[2] : xv[3];
                const float v = (y + Dh * xt) * silu(z);
                Y[row * 4096 + 64 * h + pp] = (bf16)f2bf(v); sstot += v * v; }
        }
    }
    sstot += __shfl_xor(sstot, 8); sstot += __shfl_xor(sstot, 16); sstot += __shfl_xor(sstot, 32);
    if (lane < 4) atomicAdd(SSQ + Rb + lane, sstot);
    LBAR();
}

DI void ret_sample_item(const Params& p, LAS unsigned char* lds, int b, int h, int pass) {
    int tid_ = threadIdx.x; asm volatile("" : "+v"(tid_)); const int tid = tid_, lane = tid & 63, w = tid >> 6;
    const bf16* PROJ = (const bf16*)(p.ws + WS_PROJ); const float* ROPE = (const float*)(p.ws + WS_ROPE);
    bf16* Y = (bf16*)(p.ws + WS_Y); float* SSQ = (float*)(p.ws + (pass ? WS_DUM + (size_t)T * 4 : WS_SSQR));
    LAS float* qs = (LAS float*)lds; LAS float* ks = qs + 1024; LAS float* qk = ks + 1024; LAS float* part = qk + 16;
    const int Rb = TP + 4 * b;
    const float lg = log1pf(-exp2f(-5.f - (float)h)), gm = __expf(lg);
    const int e4 = tid & 127, dg = tid >> 7;
    u32x2 vraw[4];
#pragma unroll
    for (int s = 0; s < 4; ++s) vraw[s] = *(const u32x2*)(PROJ + (size_t)(Rb + s) * NPROJ + PV + 512 * h + 4 * e4);
    { const int t = tid >> 7, i = tid & 127; const bf16* prow = PROJ + (size_t)(Rb + t) * NPROJ;
      const float q1 = __uint_as_float((unsigned)prow[PQ + 256 * h + i] << 16), q2 = __uint_as_float((unsigned)prow[PQ + 256 * h + 128 + i] << 16);
      const float k1 = __uint_as_float((unsigned)prow[PK + 256 * h + i] << 16), k2 = __uint_as_float((unsigned)prow[PK + 256 * h + 128 + i] << 16);
      const unsigned rw = ((const unsigned*)ROPE)[(size_t)(2048 + t) * 128 + i]; const float c = h2lo(rw), s = h2hi(rw);
      qs[t * 256 + i] = q1 * c - q2 * s; qs[t * 256 + 128 + i] = q1 * s + q2 * c; ks[t * 256 + i] = k1 * c - k2 * s; ks[t * 256 + 128 + i] = k1 * s + k2 * c; }
    LBAR();
#pragma unroll
    for (int i = 0; i < 2; ++i) { const int idx = 2 * w + i, t = idx >> 2, s = idx & 3; float d = 0.f;
#pragma unroll
        for (int j = 0; j < 4; ++j) d += qs[t * 256 + lane + 64 * j] * ks[s * 256 + lane + 64 * j];
        d = wave_sum(d); if (lane == 0) qk[idx] = d; }
    f32x4 vv[4];
#pragma unroll
    for (int s = 0; s < 4; ++s) vv[s] = (f32x4){bflo(vraw[s].x), bfhi(vraw[s].x), bflo(vraw[s].y), bfhi(vraw[s].y)};
    const float g1 = gm, g2 = gm * gm, g3 = g2 * gm, g4 = g2 * g2;
    f32x4 kv2[4];
    kv2[0] = vv[0] * g3; kv2[1] = vv[1] * g2; kv2[2] = vv[2] * g1; kv2[3] = vv[3];
    f32x4 a0 = (f32x4){0.f, 0.f, 0.f, 0.f}, a1 = a0, a2 = a0, a3 = a0;
    const size_t sbase = (size_t)(b * 4 + h) * 256 * 512 + 4 * e4;
    const float* h0 = p.in[I_SRET] + sbase; float* h1 = p.out + O_RETS + sbase;
    for (int d0 = 64 * dg; d0 < 64 * dg + 64; d0 += 8) {
        f32x4 hv[8];
#pragma unroll
        for (int j = 0; j < 8; ++j) hv[j] = __builtin_nontemporal_load((const f32x4*)(h0 + (size_t)(d0 + j) * 512));
#pragma unroll
        for (int j = 0; j < 8; ++j) { const int d = d0 + j;
            a0 += qs[d] * hv[j]; a1 += qs[256 + d] * hv[j]; a2 += qs[512 + d] * hv[j]; a3 += qs[768 + d] * hv[j];
            const f32x4 hn = hv[j] * g4 + ks[d] * kv2[0] + ks[256 + d] * kv2[1] + ks[512 + d] * kv2[2] + ks[768 + d] * kv2[3];
            __builtin_nontemporal_store(hn, (f32x4*)(h1 + (size_t)d * 512)); }
    }
    *(LAS f32x4*)(part + (dg * 4 + 0) * 512 + 4 * e4) = a0; *(LAS f32x4*)(part + (dg * 4 + 1) * 512 + 4 * e4) = a1;
    *(LAS f32x4*)(part + (dg * 4 + 2) * 512 + 4 * e4) = a2; *(LAS f32x4*)(part + (dg * 4 + 3) * 512 + 4 * e4) = a3;
    LBAR();
    { const int t = dg; f32x4 st = *(LAS f32x4*)(part + (0 * 4 + t) * 512 + 4 * e4) + *(LAS f32x4*)(part + (1 * 4 + t) * 512 + 4 * e4) + *(LAS f32x4*)(part + (2 * 4 + t) * 512 + 4 * e4) + *(LAS f32x4*)(part + (3 * 4 + t) * 512 + 4 * e4);
      const float qd = (t == 0) ? g1 : (t == 1) ? g2 : (t == 2) ? g3 : g4;
      f32x4 y = st * qd;
#pragma unroll
      for (int s = 0; s < 4; ++s) { if (s <= t) { const int df = t - s; const float gd = (df == 0) ? 1.f : (df == 1) ? g1 : (df == 2) ? g2 : g3; y += (qk[t * 4 + s] * gd) * vv[s]; } }
      const size_t row = (size_t)(Rb + t);
      float ss = (y[0] * y[0] + y[1] * y[1]) + (y[2] * y[2] + y[3] * y[3]); ss = wave_sum(ss);
      if (lane == 0) atomicAdd(SSQ + row * 4 + h, ss);
      u32x2 o; o.x = pk2(y[0], y[1]); o.y = pk2(y[2], y[3]); *(u32x2*)(Y + row * 4096 + 2048 + 512 * h + 4 * e4) = o; }
    LBAR();
}

DI void phase_ynorm(const Params& p, int G) {
    int tid_ = threadIdx.x; asm volatile("" : "+v"(tid_)); const int lane = tid_ & 63, w = tid_ >> 6; const int gw = blockIdx.x * NWV + w, NGW = G * NWV;
    bf16* Y = (bf16*)(p.ws + WS_Y); const bf16* PROJ = (const bf16*)(p.ws + WS_PROJ);
    const float* SSQR = (const float*)(p.ws + WS_SSQR); const float* gr = p.in[I_RETN];
    for (int m = gw; m < T; m += 4 * NGW) {
        u32x4 yv[4][4], gv[4][4]; f32x4 sq[4]; bool ok[4]; int mc[4];
#pragma unroll
        for (int r = 0; r < 4; ++r) { const int mr = m + r * NGW; ok[r] = mr < T; mc[r] = ok[r] ? mr : m; sq[r] = *(const f32x4*)(SSQR + (size_t)mc[r] * 4);
#pragma unroll
            for (int j = 0; j < 4; ++j) { const int c = 8 * (lane + 64 * j); yv[r][j] = __builtin_nontemporal_load((const u32x4*)(Y + (size_t)mc[r] * 4096 + 2048 + c)); gv[r][j] = __builtin_nontemporal_load((const u32x4*)(PROJ + (size_t)mc[r] * NPROJ + PRG + c)); } }
#pragma unroll
        for (int r = 0; r < 4; ++r) { if (ok[r]) {
#pragma unroll
            for (int j = 0; j < 4; ++j) { const int c = 8 * (lane + 64 * j);
                const float rr = __builtin_amdgcn_rsqf(sq[r][j] * (1.f / 512.f) + 1e-6f);
                const u32x4 v = yv[r][j], gt = gv[r][j]; const f32x4 g0 = *(const f32x4*)(gr + c), g1 = *(const f32x4*)(gr + c + 4); u32x4 o;
                o.x = pk2(bflo(v.x) * rr * g0[0] * silu(bflo(gt.x)), bfhi(v.x) * rr * g0[1] * silu(bfhi(gt.x))); o.y = pk2(bflo(v.y) * rr * g0[2] * silu(bflo(gt.y)), bfhi(v.y) * rr * g0[3] * silu(bfhi(gt.y)));
                o.z = pk2(bflo(v.z) * rr * g1[0] * silu(bflo(gt.z)), bfhi(v.z) * rr * g1[1] * silu(bfhi(gt.z))); o.w = pk2(bflo(v.w) * rr * g1[2] * silu(bflo(gt.w)), bfhi(v.w) * rr * g1[3] * silu(bfhi(gt.w)));
                *(u32x4*)(Y + (size_t)mc[r] * 4096 + 2048 + c) = o; } } }
    }
}

#ifndef REP_P4
#define REP_P4 1
#endif
#ifndef REP_SMALL
#define REP_SMALL 1
#endif
#ifndef P0_REP
#define P0_REP 0
#endif
#ifndef NPASS
#define NPASS 1
#endif
#ifndef PROBE_MASK
#define PROBE_MASK 15
#endif
#define GEMM_PHASE(EpiT, Aptr, Bptr, Nn, Kk, LDA, LDB, Eobj) do { pg8::Gemm g_{(const pg8::bf16_t*)(Aptr), (const pg8::bf16_t*)(Bptr), T, (Nn), (Kk), (LDA), (LDB)}; pg8::StaticOrder S_; S_.init(T, (Nn), (Kk), G, (int)blockIdx.x); \
    pg8::gemm_phase<EpiT, pg8::StaticOrder, true, true>(lds, g_, S_, (Eobj)); } while (0)

#define GEMM_SPLIT(EpiT, Aptr, Bptr, Kk, Kc, LDA, LDB, Eobj) do { pg8::Gemm g_{(const pg8::bf16_t*)(Aptr), (const pg8::bf16_t*)(Bptr), T, 1024, (Kk), (LDA), (LDB)}; pg8::SplitOrder S_; S_.init(1024, (Kk), (Kc), G, (int)blockIdx.x); \
    pg8::gemm_phase<EpiT, pg8::SplitOrder, true, true>(lds, g_, S_, (Eobj)); } while (0)

__global__ void __launch_bounds__(NTHR) mega_fwd(Params p) {
    extern __shared__ __attribute__((aligned(16))) unsigned char lds_raw[];
    LAS unsigned char* lds = (LAS unsigned char*)lds_raw;
    cg::grid_group grid = cg::this_grid();
    const int G = gridDim.x; unsigned char* ws = p.ws;
    bf16* XN = (bf16*)(ws + WS_XN); bf16* ACT = (bf16*)(ws + WS_ACT); float* H1 = (float*)(ws + WS_H1); bf16* PROJ = (bf16*)(ws + WS_PROJ);
    bf16* Yb = (bf16*)(ws + WS_Y); float* PART = (float*)(ws + WS_ACT); bf16* MERGED = (bf16*)(ws + WS_XN);

    unsigned* bw = (unsigned*)(ws + WS_BAR);
    if (threadIdx.x < 2) ((volatile LAS unsigned*)(lds + LDS_BYTES - 64))[threadIdx.x] = 0u;
    if (ws == nullptr) grid.sync();
    if (blockIdx.x == 0) {
        for (int i = threadIdx.x; i < 3584; i += NTHR) __hip_atomic_store(bw + i, 0u, __ATOMIC_RELAXED, __HIP_MEMORY_SCOPE_AGENT);
        asm volatile("s_waitcnt vmcnt(0)" ::: "memory"); __syncthreads();
        if (threadIdx.x == 0) { __builtin_amdgcn_fence(__ATOMIC_RELEASE, "agent"); __hip_atomic_store(bw + 3840, 0x600DF1A9u, __ATOMIC_RELAXED, __HIP_MEMORY_SCOPE_AGENT); }
    }
    phase0(p, lds, G, 7);
    phase0(p, lds, G, P0_REP);
    if (blockIdx.x != 0 && threadIdx.x == 0) { unsigned sp = 0; while (__hip_atomic_load(bw + 3840, __ATOMIC_RELAXED, __HIP_MEMORY_SCOPE_AGENT) != 0x600DF1A9u) { __builtin_amdgcn_s_sleep(2); if (++sp > (1u << 22)) break; }
        __builtin_amdgcn_fence(__ATOMIC_ACQUIRE, "agent"); asm volatile("s_waitcnt vmcnt(0)" ::: "memory"); }
    __syncthreads();
    const XcdBarrier bar = xcd_barrier_post(bw, (volatile LAS unsigned*)(lds + LDS_BYTES - 64));
    xcd_barrier(bar);
    { EpiSwiGLU E{ACT}; GEMM_PHASE(EpiSwiGLU, XN, ws + WS_W13A, 5632, 1024, 1024, 1024, E); }
    xcd_barrier(bar);
    float* SL = (float*)(ws + WS_PARTS);
    { EpiRes E{p.in[I_XP], p.in[I_XS], H1, 0.5f, SL}; GEMM_SPLIT(EpiRes, ACT, ws + WS_W2A, FF, 256, FF, FF, E); }
    xcd_barrier(bar);
    phase_rms(H1, p.in[I_NMIX], XN, G, p.in[I_XS], SL, 11);
    xcd_barrier(bar);
    for (int rep = 0; rep < REP_P4; ++rep) { EpiProj E{PROJ, (float*)(ws + WS_DT), p.in[I_DTB]}; GEMM_PHASE(EpiProj, XN, ws + WS_WIN, NPK, 1024, 1024, 1024, E); }
    xcd_barrier(bar);
    phase_conv(p, G);
    xcd_barrier(bar);
    {
        const int bx = blockIdx.x; const int vcu = (G % 8 == 0) ? (bx % 8) * (G / 8) + bx / 8 : bx;
        const bool samples_first = (bx & 1) != 0;
        for (int pass = 0; pass < NPASS; ++pass)
        for (int ph = 0; ph < 2; ++ph) {
            if ((ph == 0) == samples_first) {
                if (pass == 0 || (PROBE_MASK & 4)) for (int i = vcu; i < 512; i += G) ret_sample_item(p, lds, i >> 2, i & 3, pass);
                if (pass == 0 || (PROBE_MASK & 8)) for (int i = vcu; i < 512; i += G) ssd_sample_group(p, lds, i >> 2, i & 3, pass);
            } else {
                if (pass == 0 || (PROBE_MASK & 1)) for (int i = vcu; i < 256; i += G) ret_prompt_item(p, lds, i >> 5, (i >> 3) & 3, i & 7, pass);
                if (pass == 0 || (PROBE_MASK & 2)) for (int i = vcu; i < 256; i += G) ssd_prompt_item(p, lds, i >> 5, i & 31, pass);
            }
        }
    }
    xcd_barrier(bar);
    phase_ynorm(p, G);
    xcd_barrier(bar);
    { EpiGate1 E{PROJ, PART, (float*)(ws + WS_PARTS), (const float*)(ws + WS_SSQS)}; GEMM_SPLIT(EpiGate1, Yb, ws + WS_WBS, 2048, 256, 4096, 2048, E); }
    { EpiGate2 E{PROJ, PART, MERGED, (float*)(ws + WS_PARTS)}; GEMM_SPLIT(EpiGate2, Yb + 2048, ws + WS_WBR, 2048, 256, 4096, 2048, E); }
    xcd_barrier(bar);
    {
        int tid_ = threadIdx.x; asm volatile("" : "+v"(tid_)); const f32x4* ps4 = (const f32x4*)SL; u32x2* mo = (u32x2*)(MERGED + (size_t)TP * 1024);
        for (int e = blockIdx.x * NTHR + tid_; e < 512 * 256; e += G * NTHR) { f32x4 v = ps4[e];
#pragma unroll
            for (int k = 1; k < 16; ++k) v += ps4[(size_t)k * 512 * 256 + e];
            u32x2 o; o.x = pk2(v[0], v[1]); o.y = pk2(v[2], v[3]); mo[e] = o; }
    }
    xcd_barrier(bar);
    { EpiRes E{H1, H1 + (size_t)TP * 1024, H1, 1.0f, SL}; GEMM_SPLIT(EpiRes, MERGED, ws + WS_WO, 1024, 256, 1024, 1024, E); }
    xcd_barrier(bar);
    phase_rms(H1, p.in[I_NF2], XN, G, H1 + (size_t)TP * 1024, SL, 4);
    xcd_barrier(bar);
    { EpiSwiGLU E{ACT}; GEMM_PHASE(EpiSwiGLU, XN, ws + WS_W13B, 5632, 1024, 1024, 1024, E); }
    xcd_barrier(bar);
    { EpiRes E{H1, H1 + (size_t)TP * 1024, p.out + O_Y, 0.5f, SL}; GEMM_SPLIT(EpiRes, ACT, ws + WS_W2B, FF, 256, FF, FF, E); }
    xcd_barrier(bar);
    {
        const float* g = p.in[I_NFIN]; int tid_ = threadIdx.x; asm volatile("" : "+v"(tid_)); const int lane = tid_ & 63, gw = blockIdx.x * NWV + (tid_ >> 6), NGW = G * NWV;
        f32x4 gg[4];
#pragma unroll
        for (int j = 0; j < 4; ++j) gg[j] = *((const f32x4*)g + lane + 64 * j);
        for (int m = gw; m < TP; m += 4 * NGW) { f32x4 v[4][4]; bool ok[4]; int mc[4];
#pragma unroll
            for (int r = 0; r < 4; ++r) { const int mr = m + r * NGW; ok[r] = mr < TP; mc[r] = ok[r] ? mr : m;
#pragma unroll
                for (int j = 0; j < 4; ++j) v[r][j] = *((const f32x4*)(p.out + O_Y + (size_t)mc[r] * 1024) + lane + 64 * j); }
#pragma unroll
            for (int r = 0; r < 4; ++r) { float s = 0.f;
#pragma unroll
                for (int j = 0; j < 4; ++j) s += (v[r][j][0] * v[r][j][0] + v[r][j][1] * v[r][j][1]) + (v[r][j][2] * v[r][j][2] + v[r][j][3] * v[r][j][3]);
                const float rstd = __builtin_amdgcn_rsqf(wave_sum(s) * (1.f / 1024.f) + 1e-6f);
                if (ok[r]) {
#pragma unroll
                    for (int j = 0; j < 4; ++j) *((f32x4*)(p.out + O_Y + (size_t)mc[r] * 1024) + lane + 64 * j) = v[r][j] * rstd * gg[j]; } } }
        for (int r = gw; r < 512; r += NGW) { f32x4 v[4]; float s = 0.f;
#pragma unroll
            for (int j = 0; j < 4; ++j) v[j] = *((const f32x4*)(H1 + (size_t)(TP + r) * 1024) + lane + 64 * j);
            for (int k = 0; k < 11; ++k) {
#pragma unroll
                for (int j = 0; j < 4; ++j) v[j] += *((const f32x4*)(SL + ((size_t)k * 512 + r) * 1024) + lane + 64 * j); }
#pragma unroll
            for (int j = 0; j < 4; ++j) s += (v[j][0] * v[j][0] + v[j][1] * v[j][1]) + (v[j][2] * v[j][2] + v[j][3] * v[j][3]);
            const float rstd = __builtin_amdgcn_rsqf(wave_sum(s) * (1.f / 1024.f) + 1e-6f);
#pragma unroll
            for (int j = 0; j < 4; ++j) *((f32x4*)(p.out + O_Y + (size_t)(TP + r) * 1024) + lane + 64 * j) = v[j] * rstd * gg[j]; }
    }
    __syncthreads();
    if (threadIdx.x == 0) { unsigned* bw2 = (unsigned*)(ws + WS_BAR); const unsigned old = __hip_atomic_fetch_add(bw2 + 3520, 1u, __ATOMIC_RELAXED, __HIP_MEMORY_SCOPE_AGENT);
        if (old == (unsigned)G - 1u) { __hip_atomic_store(bw2 + 3840, 0u, __ATOMIC_RELAXED, __HIP_MEMORY_SCOPE_AGENT); __hip_atomic_store(bw2 + 3520, 0u, __ATOMIC_RELAXED, __HIP_MEMORY_SCOPE_AGENT); } }
}

extern "C" void kernel_launch(void* const* d_in, const int* in_sizes, int n_in, void* d_out, int out_size, void* d_ws, size_t ws_size, hipStream_t stream) {
    static int grid = 0;
    if (grid == 0) {
        if (n_in != 26 || ws_size < WS_END) { fprintf(stderr, "kernel_launch: need 26 inputs and %zu bytes of workspace (got %d, %zu)\n", (size_t)WS_END, n_in, ws_size); grid = -1; return; }
        int dev = 0, cus = 0, per_cu = 0;
        hipGetDevice(&dev); hipDeviceGetAttribute(&cus, hipDeviceAttributeMultiprocessorCount, dev);
        if (hipFuncSetAttribute((const void*)mega_fwd, hipFuncAttributeMaxDynamicSharedMemorySize, LDS_BYTES) != hipSuccess) { fprintf(stderr, "kernel_launch: hipFuncSetAttribute failed\n"); grid = -1; return; }
        if (hipOccupancyMaxActiveBlocksPerMultiprocessor(&per_cu, (const void*)mega_fwd, NTHR, LDS_BYTES) != hipSuccess || per_cu < 1) { fprintf(stderr, "kernel_launch: occupancy query says %d\n", per_cu); grid = -1; return; }
        grid = cus * 1;
    }
    if (grid < 0) return;
    Params p{};
    for (int i = 0; i < 26; ++i) p.in[i] = (const float*)d_in[i];
    p.out = (float*)d_out; p.ws = (unsigned char*)d_ws;
    void* args[] = {&p};
    hipError_t e = hipLaunchCooperativeKernel((const void*)mega_fwd, dim3(grid), dim3(NTHR), args, LDS_BYTES, stream);
    if (e != hipSuccess) fprintf(stderr, "cooperative launch failed: %s (grid %d)\n", hipGetErrorString(e), grid);
}
```
